# Optimizing an MI355X kernel written in HIP

```python
import jax
import jax.numpy as jnp
from jax import lax
import numpy as np


D_MODEL = 1024
BATCH = 4
SEQ = 4096
DEPTH = 2

MEM_LEN = 256
A_HEADS = 4
A_DIM = 128
B_HEADS = 4
B_DK = 128
B_DV = 128
CONV_W = 4
CHUNK = 64
C_HEADS = 8
C_DIM = D_MODEL // C_HEADS
Q_BLOCK = 128
X_HEADS = 4
X_DIM = D_MODEL // X_HEADS
D_FF = 4 * D_MODEL
EPS = 1e-6
N_EVEN = (DEPTH + 1) // 2
N_ODD = DEPTH // 2
A_W = A_HEADS * A_DIM
B_KW = B_HEADS * B_DK
B_VW = B_HEADS * B_DV
AB_SIZES = (A_W, A_W, A_W, A_W, A_HEADS, A_HEADS, B_KW, B_KW, B_VW, B_VW)
AB_IN = 4 * A_W + 2 * A_HEADS + 2 * B_KW + 2 * B_VW
C_SIZES = (D_MODEL, D_MODEL, D_MODEL, D_MODEL, C_HEADS)
C_IN = 4 * D_MODEL + C_HEADS

kernel_name = 'hybrid_mlstm_hgrn2_fox_trunk'


def _split(z, sizes):
    offs = [int(o) for o in np.cumsum(sizes)[:-1]]
    return jnp.split(z, offs, axis=-1)


def rmsnorm(x, g):
    xf = x.astype(jnp.float32)
    y = xf * lax.rsqrt(jnp.mean(xf * xf, axis=-1, keepdims=True) + EPS)
    return (y * g.astype(jnp.float32)).astype(x.dtype)


def _heads(a, h):
    return a.reshape(a.shape[0], a.shape[1], h, -1)


def _to_chunks(a):
    b, s, h = a.shape[:3]
    a = a.reshape((b, s // CHUNK, CHUNK, h) + a.shape[3:])
    return jnp.moveaxis(a, (1, 3), (0, 2))


def _from_chunks(a):
    a = jnp.moveaxis(a, (0, 2), (1, 3))
    return a.reshape((a.shape[0], a.shape[1] * a.shape[2]) + a.shape[3:])


def causal_conv_silu(u, w):
    s = u.shape[1]
    up = jnp.pad(u, ((0, 0), (CONV_W - 1, 0), (0, 0)))
    y = up[:, 0:s] * w[0]
    for j in range(1, CONV_W):
        y = y + up[:, j:j + s] * w[j]
    return jax.nn.silu(y)


def mlstm_chunkwise(q, k, v, i_pre, f_pre):
    bn, s, h, d = q.shape
    q = q.astype(jnp.float32)
    k = k.astype(jnp.float32) * (d ** -0.5)
    v = v.astype(jnp.float32)
    logf = jax.nn.log_sigmoid(f_pre)
    xs = (_to_chunks(q), _to_chunks(k), _to_chunks(v), _to_chunks(i_pre), _to_chunks(logf))
    causal = jnp.tril(jnp.ones((CHUNK, CHUNK), dtype=bool))

    def step(carry, inp):
        cmat, nvec, m = carry
        qb, kb, vb, ib, fb = inp
        bcum = jnp.cumsum(fb, axis=-1)
        logd = bcum[..., :, None] - bcum[..., None, :] + ib[..., None, :]
        logd = jnp.where(causal, logd, -jnp.inf)
        inter = bcum + m[..., None]
        m_t = jnp.maximum(inter, jnp.max(logd, axis=-1))
        w_inter = jnp.exp(inter - m_t)
        sc = jnp.einsum('bhtd,bhsd->bhts', qb, kb) * jnp.exp(logd - m_t[..., None])
        num = (jnp.einsum('bhts,bhsd->bhtd', sc, vb)
               + w_inter[..., None] * jnp.einsum('bhtd,bhde->bhte', qb, cmat))
        den = jnp.sum(sc, axis=-1) + w_inter * jnp.einsum('bhtd,bhd->bht', qb, nvec)
        hout = num / jnp.maximum(jnp.abs(den), jnp.exp(-m_t))[..., None]
        b_last = bcum[..., -1]
        log_in = b_last[..., None] - bcum + ib
        m_new = jnp.maximum(b_last + m, jnp.max(log_in, axis=-1))
        w_s = jnp.exp(log_in - m_new[..., None])
        decay = jnp.exp(b_last + m - m_new)
        c_new = decay[..., None, None] * cmat + jnp.einsum('bhs,bhsd,bhse->bhde', w_s, kb, vb)
        n_new = decay[..., None] * nvec + jnp.einsum('bhs,bhsd->bhd', w_s, kb)
        return (c_new, n_new, m_new), hout

    init = (jnp.zeros((bn, h, d, d), jnp.float32), jnp.zeros((bn, h, d), jnp.float32),
            jnp.zeros((bn, h), jnp.float32))
    _, hs = lax.scan(step, init, xs)
    return _from_chunks(hs)


def hgrn2_chunkwise(q, k, v, logf):
    bn, s, h, dk = q.shape
    dv = v.shape[-1]
    xs = (_to_chunks(q), _to_chunks(k), _to_chunks(v), _to_chunks(logf))
    causal = jnp.tril(jnp.ones((CHUNK, CHUNK), dtype=bool))[:, :, None]

    def step(state, inp):
        qb, kb, vb, gb = inp
        bcum = jnp.cumsum(gb, axis=2)
        rel = bcum[:, :, :, None, :] - bcum[:, :, None, :, :]
        rel = jnp.where(causal, rel, -jnp.inf)
        a = jnp.einsum('bhtc,bhsc,bhtsc->bhts', qb, kb, jnp.exp(rel))
        o = (jnp.einsum('bhts,bhse->bhte', a, vb)
             + jnp.einsum('bhtc,bhce->bhte', qb * jnp.exp(bcum), state))
        b_last = bcum[:, :, -1]
        s_new = (jnp.exp(b_last)[..., None] * state
                 + jnp.einsum('bhsc,bhse->bhce', kb * jnp.exp(b_last[:, :, None] - bcum), vb))
        return s_new, o

    _, os_ = lax.scan(step, jnp.zeros((bn, h, dk, dv), jnp.float32), xs)
    return _from_chunks(os_)


def forgetting_attention(q, k, v, logf):
    bn, s, h, d = q.shape
    nb = s // Q_BLOCK
    c = jnp.moveaxis(jnp.cumsum(logf, axis=1), 1, 2)
    qb = q.reshape(bn, nb, Q_BLOCK, h, d).transpose(1, 0, 3, 2, 4)
    cq = c.reshape(bn, h, nb, Q_BLOCK).transpose(2, 0, 1, 3)
    kpos = jnp.arange(s)

    def block(args):
        qi, cqi, bidx = args
        qpos = bidx * Q_BLOCK + jnp.arange(Q_BLOCK)
        logits = (jnp.einsum('bhqd,bshd->bhqs', qi, k).astype(jnp.float32) * (d ** -0.5)
                  + cqi[..., None] - c[:, :, None, :])
        logits = jnp.where(kpos[None, :] <= qpos[:, None], logits, -jnp.inf)
        p = jax.nn.softmax(logits, axis=-1)
        return jnp.einsum('bhqs,bshd->bqhd', p.astype(v.dtype), v)

    out = lax.map(block, (qb, cq, jnp.arange(nb)))
    return out.transpose(1, 0, 2, 3, 4).reshape(bn, s, h, d)


def mixer_ab(u, w_in, conv_w, gate_b, lb, norm_a, norm_b, w_out):
    bn, s, _ = u.shape
    z = u @ w_in
    qa, ka, va, oa, ia, fa, qb, fb, ib, gb = _split(z, AB_SIZES)
    qa, ka = jnp.split(causal_conv_silu(jnp.concatenate([qa, ka], axis=-1), conv_w), 2, axis=-1)
    gates = jnp.concatenate([ia, fa], axis=-1).astype(jnp.float32) + gate_b
    i_pre, f_pre = jnp.split(gates, 2, axis=-1)
    ha = mlstm_chunkwise(_heads(qa, A_HEADS), _heads(ka, A_HEADS), _heads(va, A_HEADS), i_pre, f_pre)
    ha = jax.nn.sigmoid(_heads(oa, A_HEADS).astype(jnp.float32)) * ha
    ha = rmsnorm(ha, norm_a.reshape(A_HEADS, A_DIM)).reshape(bn, s, A_W)
    zf = fb.astype(jnp.float32)
    logf = jnp.log(lb + (1.0 - lb) * jax.nn.sigmoid(zf))
    kf = (1.0 - lb) * jax.nn.sigmoid(-zf)
    hb = hgrn2_chunkwise(_heads(jax.nn.silu(qb.astype(jnp.float32)), B_HEADS), _heads(kf, B_HEADS),
                         _heads(jax.nn.silu(ib.astype(jnp.float32)), B_HEADS), _heads(logf, B_HEADS))
    hb = rmsnorm(hb, norm_b.reshape(B_HEADS, B_DV)) * jax.nn.silu(_heads(gb, B_HEADS).astype(jnp.float32))
    hb = hb.reshape(bn, s, B_VW)
    y = jnp.concatenate([ha, hb], axis=-1).astype(u.dtype)
    return y @ w_out


def mixer_c(u, w_in, f_b, q_norm, k_norm, w_out):
    bn, s, _ = u.shape
    z = u @ w_in
    q, k, v, g, f = _split(z, C_SIZES)
    q = rmsnorm(_heads(q, C_HEADS), q_norm)
    k = rmsnorm(_heads(k, C_HEADS), k_norm)
    logf = jax.nn.log_sigmoid(f.astype(jnp.float32) + f_b)
    o = forgetting_attention(q, k, _heads(v, C_HEADS), logf).reshape(bn, s, D_MODEL)
    o = (o.astype(jnp.float32) * jax.nn.sigmoid(g.astype(jnp.float32))).astype(u.dtype)
    return o @ w_out


def memory_cross_attention(u, mem_k, mem_v, w_q, w_o):
    bn, s, _ = u.shape
    q = _heads(u @ w_q, X_HEADS)
    logits = jnp.einsum('bshd,bmhd->bhsm', q, mem_k).astype(jnp.float32) * (X_DIM ** -0.5)
    p = jax.nn.softmax(logits, axis=-1)
    o = jnp.einsum('bhsm,bmhd->bshd', p.astype(mem_v.dtype), mem_v).reshape(bn, s, D_MODEL)
    return o @ w_o


def squared_relu_mlp(u, w1, w2):
    return jnp.square(jax.nn.relu(u @ w1)) @ w2


def setup_inputs(seed: int = 0) -> dict:
    key = jax.random.key(seed)
    ks = jax.random.split(key, 32)

    def nrm(k, shape):
        return jax.random.normal(k, shape, jnp.float32)

    def dense(k, shape, fan_in):
        return nrm(k, shape) * (fan_in ** -0.5)

    def gain(k, shape):
        return 1.0 + 0.02 * nrm(k, shape)

    ab_gate_b = jnp.concatenate(
        [0.1 * nrm(ks[10], (N_EVEN, A_HEADS)),
         jnp.linspace(3.0, 6.0, A_HEADS)[None, :] + 0.1 * nrm(ks[11], (N_EVEN, A_HEADS))], axis=-1)
    c_fgate_b = jnp.linspace(1.0, 5.0, C_HEADS)[None, :] + 0.1 * nrm(ks[17], (N_ODD, C_HEADS))
    return {
        'x': nrm(ks[0], (BATCH, SEQ, D_MODEL)),
        'mem': nrm(ks[1], (BATCH, MEM_LEN, D_MODEL)),
        'norm_mix_g': gain(ks[2], (DEPTH, D_MODEL)),
        'norm_xattn_g': gain(ks[3], (DEPTH, D_MODEL)),
        'norm_mlp_g': gain(ks[4], (DEPTH, D_MODEL)),
        'final_norm_g': gain(ks[5], (D_MODEL,)),
        'ab_w_in': dense(ks[6], (N_EVEN, D_MODEL, AB_IN), D_MODEL),
        'ab_conv_w': dense(ks[7], (N_EVEN, CONV_W, 2 * A_W), CONV_W),
        'ab_gate_b': ab_gate_b,
        'hgrn_lb_logits': 0.1 * nrm(ks[8], (N_EVEN + 1, B_KW)),
        'mlstm_norm_g': gain(ks[9], (N_EVEN, A_W)),
        'hgrn_norm_g': gain(ks[12], (N_EVEN, B_VW)),
        'ab_w_out': dense(ks[13], (N_EVEN, A_W + B_VW, D_MODEL), A_W + B_VW),
        'c_w_in': dense(ks[14], (N_ODD, D_MODEL, C_IN), D_MODEL),
        'c_fgate_b': c_fgate_b,
        'c_qnorm_g': gain(ks[15], (N_ODD, C_DIM)),
        'c_knorm_g': gain(ks[16], (N_ODD, C_DIM)),
        'c_w_out': dense(ks[18], (N_ODD, D_MODEL, D_MODEL), D_MODEL),
        'mem_norm_g': gain(ks[19], (D_MODEL,)),
        'mem_w_kv': dense(ks[20], (D_MODEL, 2 * D_MODEL), D_MODEL),
        'xa_w_q': dense(ks[21], (DEPTH, D_MODEL, D_MODEL), D_MODEL),
        'xa_w_o': dense(ks[22], (DEPTH, D_MODEL, D_MODEL), D_MODEL),
        'mlp_w1': dense(ks[23], (DEPTH, D_MODEL, D_FF), D_MODEL),
        'mlp_w2': dense(ks[24], (DEPTH, D_FF, D_MODEL), D_FF),
    }


def reference(x, mem, norm_mix_g, norm_xattn_g, norm_mlp_g, final_norm_g,
              ab_w_in, ab_conv_w, ab_gate_b, hgrn_lb_logits, mlstm_norm_g, hgrn_norm_g, ab_w_out,
              c_w_in, c_fgate_b, c_qnorm_g, c_knorm_g, c_w_out,
              mem_norm_g, mem_w_kv, xa_w_q, xa_w_o, mlp_w1, mlp_w2):
    bn, m_len, _ = mem.shape
    mem_k, mem_v = jnp.split(rmsnorm(mem, mem_norm_g) @ mem_w_kv, 2, axis=-1)
    mem_k = mem_k.reshape(bn, m_len, X_HEADS, X_DIM)
    mem_v = mem_v.reshape(bn, m_len, X_HEADS, X_DIM)
    lb_all = jnp.cumsum(jax.nn.softmax(hgrn_lb_logits.astype(jnp.float32), axis=0), axis=0)
    h = x
    for layer in range(DEPTH):
        u = rmsnorm(h, norm_mix_g[layer])
        if layer % 2 == 0:
            e = layer // 2
            h = h + mixer_ab(u, ab_w_in[e], ab_conv_w[e], ab_gate_b[e], lb_all[e],
                             mlstm_norm_g[e], hgrn_norm_g[e], ab_w_out[e])
        else:
            o = layer // 2
            h = h + mixer_c(u, c_w_in[o], c_fgate_b[o], c_qnorm_g[o], c_knorm_g[o], c_w_out[o])
        h = h + memory_cross_attention(rmsnorm(h, norm_xattn_g[layer]), mem_k, mem_v,
                                       xa_w_q[layer], xa_w_o[layer])
        h = h + squared_relu_mlp(rmsnorm(h, norm_mlp_g[layer]), mlp_w1[layer], mlp_w2[layer])
    return rmsnorm(h, final_norm_g)
```

```cpp
#include <hip/hip_runtime.h>
#include <hip/hip_cooperative_groups.h>
#include <cstdio>
#include <cstdint>
namespace cg = cooperative_groups;
namespace pg8 {
#define PG8_LAS __attribute__((address_space(3)))
typedef unsigned short bf16_t;
typedef short bf16x8 __attribute__((ext_vector_type(8)));
typedef float f32x4 __attribute__((ext_vector_type(4)));
typedef unsigned u32x4 __attribute__((ext_vector_type(4)));
constexpr int BM = 256, BK = 64, HALF = 128, HTB = HALF * BK * 2  , STAGE_BYTES = 8 * HTB, NXCD = 8, WGM = 4;

__host__ __device__ __forceinline__ int lds_byte(int r, int c) { const int st = (r >> 4) * 2 + (c >> 5), rr = r & 15, cc = c & 31, ob = rr * 64 + cc * 2; return st * 1024 + (ob ^ (((ob >> 9) & 1) << 5)); }
__host__ __device__ __forceinline__ void stage_rc(int b, int& R, int& C) { const int st = b / 1024, sb = b % 1024, swz = sb ^ (((sb >> 9) & 1) << 5); R = (st >> 1) * 16 + swz / 64; C = (st & 1) * 32 + (swz % 64) / 2; }
__host__ __device__ __forceinline__ int perm32(int rho) { const int n = rho >> 4, i = rho & 15; return 8 * (i >> 2) + 4 * n + (i & 3); }

typedef PG8_LAS float* PG8F;
struct Unit { int pm, pn; };
struct Gemm { const bf16_t* A; const bf16_t* Bt; int M, N, K; };

struct StaticOrder {
    int nM, nN, nwg, G, c;
    __host__ __device__ __forceinline__ void init(int M, int N, int G_, int c_) { nM = M / BM; nN = N / BM; nwg = nM * nN; G = G_; c = c_; }
    __host__ __device__ __forceinline__ bool next(int i, Unit& u) const {
        const long L = (long)i * G + c; if (L >= nwg) return false;
        int wgid = (int)L; { const int q = nwg / NXCD, r = nwg % NXCD, xcd = wgid % NXCD, off = wgid / NXCD; wgid = (xcd < r ? xcd * (q + 1) : r * (q + 1) + (xcd - r) * q) + off; }
        const int nig = WGM * nN, gid = wgid / nig, fm = gid * WGM, gsz = (nM - fm) < WGM ? (nM - fm) : WGM;
        u.pm = fm + ((wgid % nig) % gsz); u.pn = (wgid % nig) / gsz; return true;
    }
    __device__ __forceinline__ void a_ready(const Unit&) const {}
    __device__ __forceinline__ void done(const Unit&) const {}
};

typedef float f32x2c __attribute__((ext_vector_type(2))); typedef __bf16 bf16x2c __attribute__((ext_vector_type(2)));
__device__ __forceinline__ unsigned cvt_pk_bf16(float lo, float hi) { const f32x2c v = {lo, hi}; return __builtin_bit_cast(unsigned, __builtin_convertvector(v, bf16x2c)); }
template <int ACT  > struct EpiBf16 {
    static constexpr bool PERM = true, AFTER_DRAIN = false;
    bf16_t* O; int ldc; float scale; const float* rs; size_t slot_stride;
    __device__ __forceinline__ void operator()(const f32x4 (&acc)[2][2][4][2], const Unit& u, int wr, int wc, int fr, int fq) const {
        const int row0 = u.pm * BM + wr * 64 + fr; const int col0 = u.pn * BM + wc * 32 + 8 * fq;
#pragma unroll
        for (int ai = 0; ai < 2; ++ai)
#pragma unroll
            for (int m = 0; m < 4; ++m) { bf16_t* rowp = slot_stride ? O + (size_t)(2 * u.pn) * slot_stride + (size_t)(row0 + ai * HALF + m * 16) * 128 + wc * 32 + 8 * fq : O + (size_t)(row0 + ai * HALF + m * 16) * ldc + col0;
                float rsc = 1.f; if (rs) { const f32x4 p4 = *(const f32x4*)(rs + (size_t)(row0 + ai * HALF + m * 16) * 4); rsc = __builtin_amdgcn_rsqf(((p4[0] + p4[1]) + (p4[2] + p4[3])) * (1.f / 1024.f) + 1e-6f); }
#pragma unroll
                for (int bj = 0; bj < 2; ++bj) { f32x4 v0 = acc[ai][bj][m][0] * rsc, v1 = acc[ai][bj][m][1] * rsc;
                    if (ACT == 2) {
#pragma unroll
                        for (int e = 0; e < 4; ++e) { float a = v0[e] > 0.f ? v0[e] : 0.f; v0[e] = a * a; float b = v1[e] > 0.f ? v1[e] : 0.f; v1[e] = b * b; } }
                    v0 = v0 * scale; v1 = v1 * scale; u32x4 w; w.x = cvt_pk_bf16(v0[0], v0[1]); w.y = cvt_pk_bf16(v0[2], v0[3]); w.z = cvt_pk_bf16(v1[0], v1[1]); w.w = cvt_pk_bf16(v1[2], v1[3]);
                    *(u32x4*)(rowp + (slot_stride ? bj * slot_stride : (size_t)(bj * HALF))) = w; } }
    }
};
struct EpiResF32 {
    static constexpr bool PERM = false, AFTER_DRAIN = false;
    const float* base; float* out; int ldc; bf16_t* hb; float* rs; PG8_LAS float* xs;
    __device__ __forceinline__ void operator()(const f32x4 (&acc)[2][2][4][2], const Unit& u, int wr, int wc, int fr, int fq) const {
        const int col0 = u.pn * BM + wc * 32 + 4 * fq;
#pragma unroll
        for (int ai = 0; ai < 2; ++ai)
#pragma unroll
            for (int m = 0; m < 4; ++m) { const size_t off = (size_t)(u.pm * BM + ai * HALF + wr * 64 + m * 16 + fr) * ldc + col0; float ssq = 0.f;
#pragma unroll
                for (int bj = 0; bj < 2; ++bj)
#pragma unroll
                    for (int n = 0; n < 2; ++n) { const f32x4 bs = *(const f32x4*)(base + off + bj * HALF + n * 16); const f32x4 v = bs + acc[ai][bj][m][n]; *(f32x4*)(out + off + bj * HALF + n * 16) = v;
                        if (hb) { ssq += (v[0] * v[0] + v[1] * v[1]) + (v[2] * v[2] + v[3] * v[3]); typedef unsigned u32x2_ __attribute__((ext_vector_type(2))); u32x2_ w; w.x = cvt_pk_bf16(v[0], v[1]); w.y = cvt_pk_bf16(v[2], v[3]); *(u32x2_*)(hb + off + bj * HALF + n * 16) = w; } }
                if (hb) { ssq += __shfl_xor(ssq, 16); ssq += __shfl_xor(ssq, 32); if (fq == 0) xs[(ai * HALF + wr * 64 + m * 16 + fr) * 4 + wc] = ssq; } }
        if (hb) {
            asm volatile("s_waitcnt lgkmcnt(0)\n\ts_barrier" ::: "memory");
            const int t_ = (wr * 4 + wc) * 64 + fq * 16 + fr;
            if (t_ < 256) { const f32x4 p4 = *(const PG8_LAS f32x4*)(xs + t_ * 4); rs[(size_t)(u.pm * BM + t_) * 4 + u.pn] = (p4[0] + p4[1]) + (p4[2] + p4[3]); } }
    }
};

struct EpiZ1 {
    static constexpr bool PERM = true, AFTER_DRAIN = false;
    bf16_t* O; size_t slot_stride; const float* gq; const float* gk; PG8_LAS float* xs; bf16_t* Vt; const float* rs;
    __device__ __forceinline__ void operator()(f32x4 (&acc)[2][2][4][2], const Unit& u, int wr, int wc, int fr, int fq) const {
        const int row0 = u.pm * BM + wr * 64 + fr; const bool qk = u.pn < 8; const bool isv = (u.pn >= 8 && u.pn < 12);
#pragma unroll
        for (int ai = 0; ai < 2; ++ai)
#pragma unroll
            for (int m = 0; m < 4; ++m) { const f32x4 p4 = *(const f32x4*)(rs + (size_t)(row0 + ai * HALF + m * 16) * 4);
                const float r_ = __builtin_amdgcn_rsqf(((p4[0] + p4[1]) + (p4[2] + p4[3])) * (1.f / 1024.f) + 1e-6f);
#pragma unroll
                for (int bj = 0; bj < 2; ++bj) { acc[ai][bj][m][0] = acc[ai][bj][m][0] * r_; acc[ai][bj][m][1] = acc[ai][bj][m][1] * r_; } }
        if (qk) {
#pragma unroll
            for (int ai = 0; ai < 2; ++ai)
#pragma unroll
                for (int m = 0; m < 4; ++m)
#pragma unroll
                    for (int bj = 0; bj < 2; ++bj) { const f32x4 v0 = acc[ai][bj][m][0], v1 = acc[ai][bj][m][1];
                        float s = ((v0[0] * v0[0] + v0[1] * v0[1]) + (v0[2] * v0[2] + v0[3] * v0[3])) + ((v1[0] * v1[0] + v1[1] * v1[1]) + (v1[2] * v1[2] + v1[3] * v1[3]));
                        s += __shfl_xor(s, 16); s += __shfl_xor(s, 32);
                        if (fq == 0) xs[((ai * HALF + wr * 64 + m * 16 + fr) * 2 + bj) * 4 + wc] = s; }
        }
        asm volatile("s_waitcnt lgkmcnt(0)\n\ts_barrier" ::: "memory");
        f32x4 gv[2][2];
        if (qk) { const float* gp = (u.pn < 4 ? gq : gk) + wc * 32 + 8 * fq; const float sc = u.pn < 4 ? 0.08838834764831845f * 1.4426950408889634f : 1.f;
#pragma unroll
            for (int bj = 0; bj < 2; ++bj) { gv[bj][0] = *(const f32x4*)gp * sc; gv[bj][1] = *(const f32x4*)(gp + 4) * sc; } }
#pragma unroll
        for (int ai = 0; ai < 2; ++ai)
#pragma unroll
            for (int m = 0; m < 4; ++m) { bf16_t* rowp = O + (size_t)(2 * u.pn) * slot_stride + (size_t)(row0 + ai * HALF + m * 16) * 128 + wc * 32 + 8 * fq;
#pragma unroll
                for (int bj = 0; bj < 2; ++bj) { f32x4 v0 = acc[ai][bj][m][0], v1 = acc[ai][bj][m][1];
                    if (qk) { const f32x4 p4 = *(const PG8_LAS f32x4*)(xs + ((ai * HALF + wr * 64 + m * 16 + fr) * 2 + bj) * 4);
                        const float r = __builtin_amdgcn_rsqf(((p4[0] + p4[1]) + (p4[2] + p4[3])) * (1.f / 128.f) + 1e-6f); v0 = v0 * r * gv[bj][0]; v1 = v1 * r * gv[bj][1]; }
                    u32x4 w; w.x = cvt_pk_bf16(v0[0], v0[1]); w.y = cvt_pk_bf16(v0[2], v0[3]); w.z = cvt_pk_bf16(v1[0], v1[1]); w.w = cvt_pk_bf16(v1[2], v1[3]);
                    if (isv) { const int row = row0 + ai * HALF + m * 16; const int bb = row >> 12, pos = row & 4095; const int hh = 2 * u.pn + bj - 16;
                        const int pk = (pos & ~63) + 32 * ((pos >> 5) & 1) + 8 * ((pos >> 2) & 3) + 4 * ((pos >> 4) & 1) + (pos & 3);
                        bf16_t* vp = Vt + ((size_t)(bb * 8 + hh) * 128 + wc * 32 + 8 * fq) * 4096 + pk; const unsigned ww[4] = {w.x, w.y, w.z, w.w};
#pragma unroll
                        for (int e = 0; e < 8; ++e) { *vp = (bf16_t)((e & 1) ? (ww[e >> 1] >> 16) : (ww[e >> 1] & 0xffffu)); vp += 4096; asm volatile("" : "+v"(vp)); } }
                    else *(u32x4*)(rowp + bj * slot_stride) = w; } }
    }
};
struct EpiResB {
    static constexpr bool PERM = true, AFTER_DRAIN = false;
    const void* base; int base_f32; bf16_t* out; float* rs; PG8_LAS float* xs;
    __device__ __forceinline__ void operator()(const f32x4 (&acc)[2][2][4][2], const Unit& u, int wr, int wc, int fr, int fq) const {
        const int row0 = u.pm * BM + wr * 64 + fr; const int col0 = u.pn * BM + wc * 32 + 8 * fq;
#pragma unroll
        for (int ai = 0; ai < 2; ++ai)
#pragma unroll
            for (int m = 0; m < 4; ++m) { const size_t off = (size_t)(row0 + ai * HALF + m * 16) * 1024 + col0; float ssq = 0.f;
#pragma unroll
                for (int bj = 0; bj < 2; ++bj) { f32x4 v0 = acc[ai][bj][m][0], v1 = acc[ai][bj][m][1];
                    if (base_f32) { const float* bp = (const float*)base + off + bj * HALF; v0 += *(const f32x4*)bp; v1 += *(const f32x4*)(bp + 4); }
                    else { const u32x4 r = *(const u32x4*)((const bf16_t*)base + off + bj * HALF);
                        v0 += (f32x4){__uint_as_float(r.x << 16), __uint_as_float(r.x & 0xffff0000u), __uint_as_float(r.y << 16), __uint_as_float(r.y & 0xffff0000u)};
                        v1 += (f32x4){__uint_as_float(r.z << 16), __uint_as_float(r.z & 0xffff0000u), __uint_as_float(r.w << 16), __uint_as_float(r.w & 0xffff0000u)}; }
                    u32x4 w; w.x = cvt_pk_bf16(v0[0], v0[1]); w.y = cvt_pk_bf16(v0[2], v0[3]); w.z = cvt_pk_bf16(v1[0], v1[1]); w.w = cvt_pk_bf16(v1[2], v1[3]);
                    *(u32x4*)(out + off + bj * HALF) = w;
                    if (rs) ssq += ((v0[0] * v0[0] + v0[1] * v0[1]) + (v0[2] * v0[2] + v0[3] * v0[3])) + ((v1[0] * v1[0] + v1[1] * v1[1]) + (v1[2] * v1[2] + v1[3] * v1[3])); }
                if (rs) { ssq += __shfl_xor(ssq, 16); ssq += __shfl_xor(ssq, 32); if (fq == 0) xs[(ai * HALF + wr * 64 + m * 16 + fr) * 4 + wc] = ssq; }
                if (base_f32 && (m & 1)) asm volatile("" ::: "memory"); }
        if (rs) {
            asm volatile("s_waitcnt lgkmcnt(0)\n\ts_barrier" ::: "memory");
            const int t_ = (wr * 4 + wc) * 64 + fq * 16 + fr;
            if (t_ < 256) { const f32x4 p4 = *(const PG8_LAS f32x4*)(xs + t_ * 4); rs[(size_t)(u.pm * BM + t_) * 4 + u.pn] = (p4[0] + p4[1]) + (p4[2] + p4[3]); } }
    }
};

struct EpiResFinal {
    static constexpr bool PERM = false, AFTER_DRAIN = false;
    const bf16_t* base; float* out; const float* gfin; float* xbuf; unsigned* cnt; PG8_LAS float* xs;
    __device__ __forceinline__ void operator()(f32x4 (&acc)[2][2][4][2], const Unit& u, int wr, int wc, int fr, int fq) const {
        const int col0 = u.pn * BM + wc * 32 + 4 * fq;
#pragma unroll
        for (int ai = 0; ai < 2; ++ai)
#pragma unroll
            for (int m = 0; m < 4; ++m) { const size_t off = (size_t)(u.pm * BM + ai * HALF + wr * 64 + m * 16 + fr) * 1024 + col0; float ssq = 0.f;
#pragma unroll
                for (int bj = 0; bj < 2; ++bj)
#pragma unroll
                    for (int n = 0; n < 2; ++n) { typedef unsigned u32x2_ __attribute__((ext_vector_type(2))); const u32x2_ r = *(const u32x2_*)(base + off + bj * HALF + n * 16);
                        f32x4 v = acc[ai][bj][m][n] + (f32x4){__uint_as_float(r.x << 16), __uint_as_float(r.x & 0xffff0000u), __uint_as_float(r.y << 16), __uint_as_float(r.y & 0xffff0000u)};
                        acc[ai][bj][m][n] = v; ssq += (v[0] * v[0] + v[1] * v[1]) + (v[2] * v[2] + v[3] * v[3]); }
                ssq += __shfl_xor(ssq, 16); ssq += __shfl_xor(ssq, 32); if (fq == 0) xs[(ai * HALF + wr * 64 + m * 16 + fr) * 4 + wc] = ssq; }
        asm volatile("s_waitcnt lgkmcnt(0)\n\ts_barrier" ::: "memory");
        const int wid = wr * 4 + wc, t_ = wid * 64 + fq * 16 + fr;
        if (t_ < 256) { const f32x4 p4 = *(const PG8_LAS f32x4*)(xs + t_ * 4);
            __hip_atomic_store(xbuf + (size_t)(u.pm * BM + t_) * 4 + u.pn, (p4[0] + p4[1]) + (p4[2] + p4[3]), __ATOMIC_RELAXED, __HIP_MEMORY_SCOPE_AGENT); }
        asm volatile("s_waitcnt vmcnt(0)" ::: "memory");
        if (wid < 4 && fq == 0 && fr == 0) __hip_atomic_fetch_add(cnt + 64 * u.pm, 1u, __ATOMIC_RELAXED, __HIP_MEMORY_SCOPE_AGENT);
        if (wid == 0) { unsigned sp = 0;
            while ((unsigned)__builtin_amdgcn_readfirstlane(__hip_atomic_load(cnt + 64 * u.pm, __ATOMIC_RELAXED, __HIP_MEMORY_SCOPE_AGENT)) < 16u) { __builtin_amdgcn_s_sleep(2); if (++sp > (1u << 22)) break; }
            __builtin_amdgcn_fence(__ATOMIC_ACQUIRE, "agent"); }
        asm volatile("s_waitcnt vmcnt(0) lgkmcnt(0)\n\ts_barrier" ::: "memory");
        f32x4 gv[2][2];
#pragma unroll
        for (int bj = 0; bj < 2; ++bj)
#pragma unroll
            for (int n = 0; n < 2; ++n) gv[bj][n] = *(const f32x4*)(gfin + col0 + bj * HALF + n * 16);
#pragma unroll
        for (int ai = 0; ai < 2; ++ai)
#pragma unroll
            for (int m = 0; m < 4; ++m) { const int row = u.pm * BM + ai * HALF + wr * 64 + m * 16 + fr; const size_t off = (size_t)row * 1024 + col0; float s = 0.f;
#pragma unroll
                for (int t = 0; t < 4; ++t) s += __hip_atomic_load(xbuf + (size_t)row * 4 + t, __ATOMIC_RELAXED, __HIP_MEMORY_SCOPE_AGENT);
                const float rstd = __builtin_amdgcn_rsqf(s * (1.f / 1024.f) + 1e-6f);
#pragma unroll
                for (int bj = 0; bj < 2; ++bj)
#pragma unroll
                    for (int n = 0; n < 2; ++n) *(f32x4*)(out + off + bj * HALF + n * 16) = acc[ai][bj][m][n] * rstd * gv[bj][n]; }
    }
};

template <class Epi, class Sched, bool ALIGN_EPI = false, bool SP2 = false>
__device__ __forceinline__ void gemm_phase(PG8_LAS unsigned char* lds, const Gemm g, const Sched& S, const Epi& E) {
    int tid = threadIdx.x; asm volatile("" : "+v"(tid)); const int wid = __builtin_amdgcn_readfirstlane(tid >> 6), lane = tid & 63, wr = wid >> 2, wc = wid & 3, fr = lane & 15, fq = lane >> 4;
    const int K = g.K, nt = K / BK;
    unsigned voffA[2], voffB[2];
#pragma unroll
    for (int i = 0; i < 2; ++i) { int R, C; stage_rc(tid * 16 + i * 8192, R, C); const int Rb = Epi::PERM ? ((R & ~31) + perm32(R & 31)) : R;
        voffA[i] = (unsigned)(R * K + C) * 2u; voffB[i] = (unsigned)(Rb * K + C) * 2u; }
    const size_t kstep = (size_t)(BK * 2);
    const size_t hstep = (size_t)HALF * K * 2;
    const size_t tstep = 2 * hstep;
    const unsigned ldsw = (unsigned)wid * 1024u;
    const int aoff = lds_byte(wr * 64 + fr, fq * 8), boff = lds_byte(wc * 32 + fr, fq * 8);
#define PG8_SA(b, h) (((b) * 2 + (h)) * HTB)
#define PG8_SB(b, h) ((4 + (b) * 2 + (h)) * HTB)
#define PG8_STAGE(bufoff, gbase, voff) do { _Pragma("unroll") for (int _i = 0; _i < 2; ++_i) \
        __builtin_amdgcn_global_load_lds((const unsigned*)((const char*)(gbase) + (voff)[_i]), (PG8_LAS unsigned*)(lds + (bufoff) + ldsw + _i * 8192), 16, 0, 0); } while (0)
#define PG8_LDA(dst, b, h) do { _Pragma("unroll") for (int m = 0; m < 4; ++m) _Pragma("unroll") for (int k = 0; k < 2; ++k) dst[m][k] = *(const PG8_LAS bf16x8*)(lds + PG8_SA(b, h) + aoff + m * 2048 + k * 1024); } while (0)
#define PG8_LDB(dst, b, h) do { _Pragma("unroll") for (int n = 0; n < 2; ++n) _Pragma("unroll") for (int k = 0; k < 2; ++k) dst[n][k] = *(const PG8_LAS bf16x8*)(lds + PG8_SB(b, h) + boff + n * 2048 + k * 1024); } while (0)
#define PG8_MMA(ai, bj, At, Bt) do { __builtin_amdgcn_s_setprio(1); _Pragma("unroll") for (int m = 0; m < 4; ++m) _Pragma("unroll") for (int n = 0; n < 2; ++n) _Pragma("unroll") for (int k = 0; k < 2; ++k) \
        acc[ai][bj][m][n] = __builtin_amdgcn_mfma_f32_16x16x32_bf16(Bt[n][k], At[m][k], acc[ai][bj][m][n], 0, 0, 0); __builtin_amdgcn_s_setprio(0); } while (0)
#define PG8_WAIT_V(n) asm volatile("s_waitcnt vmcnt(" #n ")" ::: "memory")
#define PG8_WAIT_L(n) asm volatile("s_waitcnt lgkmcnt(" #n ")" ::: "memory")
#define PG8_BAR __builtin_amdgcn_s_barrier()
#define PG8_SCHED __builtin_amdgcn_sched_barrier(0)
    Unit cur, nxt; int ui = 0;
    if (!S.next(0, cur)) return;
    f32x4 acc[2][2][4][2];
#pragma unroll
    for (int a = 0; a < 2; ++a)
#pragma unroll
        for (int b = 0; b < 2; ++b)
#pragma unroll
            for (int m = 0; m < 4; ++m)
#pragma unroll
                for (int n = 0; n < 2; ++n) acc[a][b][m][n] = (f32x4){0.f, 0.f, 0.f, 0.f};
    bf16x8 At[4][2], B0[2][2], B1[2][2];
    const char* cA = (const char*)g.A + (size_t)cur.pm * tstep; const char* cB = (const char*)g.Bt + (size_t)cur.pn * tstep;
    S.a_ready(cur);
    if constexpr (SP2) {
        PG8_STAGE(PG8_SB(0, 0), cB, voffB); PG8_STAGE(PG8_SB(0, 1), cB + hstep, voffB); PG8_STAGE(PG8_SA(0, 0), cA, voffA); PG8_STAGE(PG8_SA(0, 1), cA + hstep, voffA);
        if (wr == 1) PG8_BAR;
        PG8_WAIT_V(2); PG8_BAR;
        PG8_STAGE(PG8_SB(1, 0), cB + kstep, voffB); PG8_STAGE(PG8_SA(1, 0), cA + kstep, voffA); PG8_STAGE(PG8_SB(1, 1), cB + hstep + kstep, voffB);
        PG8_WAIT_V(6); PG8_BAR;
    } else {
        PG8_STAGE(PG8_SB(0, 0), cB, voffB); PG8_STAGE(PG8_SA(0, 0), cA, voffA); PG8_STAGE(PG8_SB(0, 1), cB + hstep, voffB); PG8_STAGE(PG8_SA(0, 1), cA + hstep, voffA);
        if (wr == 1) PG8_BAR;
        PG8_WAIT_V(4); PG8_BAR;
        PG8_STAGE(PG8_SB(1, 0), cB + kstep, voffB); PG8_STAGE(PG8_SA(1, 0), cA + kstep, voffA); PG8_STAGE(PG8_SB(1, 1), cB + hstep + kstep, voffB);
        PG8_WAIT_V(6); PG8_BAR;
    }
    for (;;) {
        const bool has_next = S.next(ui + 1, nxt);
        const char* nA = has_next ? (const char*)g.A + (size_t)nxt.pm * tstep : cA; const char* nB = has_next ? (const char*)g.Bt + (size_t)nxt.pn * tstep : cB;
        for (int t = 0; t < nt; t += 2) {
            const bool last = (t == nt - 2);
            const char* a1 = cA + (size_t)(t + 1) * kstep;
            const char* a2 = last ? nA : cA + (size_t)(t + 2) * kstep; const char* b2 = last ? nB : cB + (size_t)(t + 2) * kstep;
            const char* a3 = a2 + kstep; const char* b3 = b2 + kstep;
            if (last && has_next) S.a_ready(nxt);
            if constexpr (SP2) {
            PG8_LDB(B0, 0, 0); PG8_LDB(B1, 0, 1); PG8_SCHED; PG8_LDA(At, 0, 0); PG8_STAGE(PG8_SA(1, 1), a1 + hstep, voffA);
            PG8_WAIT_V(8); PG8_WAIT_L(0); PG8_BAR; PG8_MMA(0, 0, At, B0); PG8_MMA(0, 1, At, B1); PG8_BAR; PG8_SCHED;
            PG8_LDA(At, 0, 1); PG8_STAGE(PG8_SB(0, 0), b2, voffB); PG8_STAGE(PG8_SB(0, 1), b2 + hstep, voffB); PG8_STAGE(PG8_SA(0, 0), a2, voffA);
            PG8_WAIT_V(8); PG8_WAIT_L(0); PG8_BAR; PG8_MMA(1, 0, At, B0); PG8_MMA(1, 1, At, B1); PG8_BAR; PG8_SCHED;
            PG8_LDB(B0, 1, 0); PG8_LDB(B1, 1, 1); PG8_SCHED; PG8_LDA(At, 1, 0); PG8_STAGE(PG8_SA(0, 1), a2 + hstep, voffA);
            PG8_WAIT_V(8); PG8_WAIT_L(0); PG8_BAR; PG8_MMA(0, 0, At, B0); PG8_MMA(0, 1, At, B1); PG8_BAR; PG8_SCHED;
            PG8_LDA(At, 1, 1); PG8_STAGE(PG8_SB(1, 0), b3, voffB); PG8_STAGE(PG8_SB(1, 1), b3 + hstep, voffB); PG8_STAGE(PG8_SA(1, 0), a3, voffA);
            PG8_WAIT_V(8); PG8_WAIT_L(0); PG8_BAR; PG8_MMA(1, 0, At, B0); PG8_MMA(1, 1, At, B1); PG8_BAR; PG8_SCHED;
            } else {
            PG8_LDB(B0, 0, 0); PG8_SCHED; PG8_LDA(At, 0, 0); PG8_STAGE(PG8_SA(1, 1), a1 + hstep, voffA);
            PG8_WAIT_L(8); PG8_BAR; PG8_WAIT_L(0); PG8_MMA(0, 0, At, B0); PG8_BAR; PG8_SCHED;
            PG8_LDB(B1, 0, 1); PG8_STAGE(PG8_SB(0, 0), b2, voffB);
            PG8_BAR; PG8_WAIT_L(0); PG8_MMA(0, 1, At, B1); PG8_BAR;
            PG8_LDA(At, 0, 1); PG8_STAGE(PG8_SA(0, 0), a2, voffA);
            PG8_BAR; PG8_WAIT_L(0); PG8_MMA(1, 0, At, B0); PG8_BAR; PG8_SCHED;
            PG8_STAGE(PG8_SB(0, 1), b2 + hstep, voffB);
            PG8_WAIT_V(6); PG8_BAR; PG8_MMA(1, 1, At, B1); PG8_BAR;
            PG8_LDB(B0, 1, 0); PG8_SCHED; PG8_LDA(At, 1, 0); PG8_STAGE(PG8_SA(0, 1), a2 + hstep, voffA);
            PG8_WAIT_L(8); PG8_BAR; PG8_WAIT_L(0); PG8_MMA(0, 0, At, B0); PG8_BAR; PG8_SCHED;
            PG8_LDB(B1, 1, 1); PG8_STAGE(PG8_SB(1, 0), b3, voffB);
            PG8_BAR; PG8_WAIT_L(0); PG8_MMA(0, 1, At, B1); PG8_BAR;
            PG8_LDA(At, 1, 1); PG8_STAGE(PG8_SA(1, 0), a3, voffA);
            PG8_BAR; PG8_WAIT_L(0); PG8_MMA(1, 0, At, B0); PG8_BAR; PG8_SCHED;
            PG8_STAGE(PG8_SB(1, 1), b3 + hstep, voffB);
            PG8_WAIT_V(6); PG8_BAR; PG8_MMA(1, 1, At, B1); PG8_BAR;
            }
        }
        if constexpr (ALIGN_EPI) { if (wr == 0) PG8_BAR; }
        if constexpr (!Epi::AFTER_DRAIN) { E(acc, cur, wr, wc, fr, fq); S.done(cur); }
        if (!has_next) break;
#pragma unroll
        for (int a = 0; a < 2; ++a)
#pragma unroll
            for (int b = 0; b < 2; ++b)
#pragma unroll
                for (int m = 0; m < 4; ++m)
#pragma unroll
                    for (int n = 0; n < 2; ++n) acc[a][b][m][n] = (f32x4){0.f, 0.f, 0.f, 0.f};
        cur = nxt; cA = nA; cB = nB; ++ui;
        if constexpr (ALIGN_EPI) { if (wr == 1) PG8_BAR; }
    }
    PG8_WAIT_V(0);
    if constexpr (!ALIGN_EPI) { if (wr == 0) PG8_BAR; }
    PG8_BAR;
    if constexpr (Epi::AFTER_DRAIN) { E.fused(acc, cur, wr, wc, fr, fq, lds, wid, lane); S.done(cur); }
#undef PG8_SA
#undef PG8_SB
#undef PG8_STAGE
#undef PG8_LDA
#undef PG8_LDB
#undef PG8_MMA
#undef PG8_WAIT_V
#undef PG8_WAIT_L
#undef PG8_BAR
#undef PG8_SCHED
}
}

#define LAS __attribute__((address_space(3)))
typedef unsigned short bf16_t;
typedef float f32x4 __attribute__((ext_vector_type(4)));
typedef short bf16x8 __attribute__((ext_vector_type(8)));
typedef unsigned u32x4 __attribute__((ext_vector_type(4)));
typedef unsigned u32x2 __attribute__((ext_vector_type(2)));
typedef float f32x2_t __attribute__((ext_vector_type(2)));
constexpr int T = 16384, DM = 1024, SEQ = 4096, FF = 4096, ZW = 4160, ZS = 16384 * 128;
constexpr size_t MiB = 1u << 20;
constexpr size_t WS_G0 = 2 * MiB;
constexpr size_t WS_FG = WS_G0 + 512 * 1024;
constexpr size_t WS_CUM = WS_FG + 512 * 1024;
constexpr size_t WS_MEMN = 4 * MiB;
constexpr size_t WS_MEMKV = 6 * MiB;
constexpr size_t WS_W = 10 * MiB;
constexpr size_t W_INA = WS_W, W_INC = WS_W + 8 * MiB, W_OUTA = WS_W + 16 * MiB, W_OUTC = WS_W + 18 * MiB, W_KV = WS_W + 20 * MiB,
                 W_Q0 = WS_W + 24 * MiB, W_Q1 = WS_W + 26 * MiB, W_O0 = WS_W + 28 * MiB, W_O1 = WS_W + 30 * MiB, W_1 = WS_W + 32 * MiB, W_2 = WS_W + 40 * MiB;
constexpr size_t WS_Z = 58 * MiB, WS_A1 = 188 * MiB, WS_A2 = 220 * MiB, WS_END = 252 * MiB;
constexpr int LDS_BYTES = 147456;
constexpr float EPS = 1e-6f;
constexpr float LOG2E = 1.4426950408889634f;

__device__ __forceinline__ float bf2f(unsigned short b) { return __uint_as_float((unsigned)b << 16); }
typedef __bf16 bf16x2_hw __attribute__((ext_vector_type(2)));
__device__ __forceinline__ unsigned pk2(float lo, float hi) { const f32x2_t v = {lo, hi}; return __builtin_bit_cast(unsigned, __builtin_convertvector(v, bf16x2_hw)); }
__device__ __forceinline__ unsigned f2bf(float f) { return pk2(f, 0.f) & 0xffffu; }
__device__ __forceinline__ float wave_sum(float v) {
#pragma unroll
    for (int o = 1; o < 64; o <<= 1) v += __shfl_xor(v, o);
    return v;
}
__device__ __forceinline__ float flogf_(float x) { return __builtin_amdgcn_logf(x) * 0.6931471805599453f; }
__device__ __forceinline__ float logsigmoidf_(float x) { return fminf(x, 0.f) - flogf_(1.f + __expf(-fabsf(x))); }
__device__ __forceinline__ float rcpf_(float x) { return __builtin_amdgcn_rcpf(x); }
__device__ __forceinline__ float sigmoidf_(float x) { return rcpf_(1.f + __expf(-x)); }
__device__ __forceinline__ float siluf_(float x) { return x * rcpf_(1.f + __expf(-x)); }

#define LBAR() asm volatile("s_waitcnt lgkmcnt(0)\n\ts_barrier" ::: "memory")
#define MFMA16(a, b, c) __builtin_amdgcn_mfma_f32_16x16x32_bf16((a), (b), (c), 0, 0, 0)
__device__ __forceinline__ bf16x8 ldf(const LAS bf16_t* p) { return *(const LAS bf16x8*)p; }

__device__ __forceinline__ void transpose_item(const float* __restrict__ W, int K, int pitch, int src_col0, bf16_t* __restrict__ WT, int dst_row0, LAS float* scr, int kb, int lane, const float* __restrict__ gk) {
    const int k0 = 64 * kb;
    float r_[32], g_[32];
#pragma unroll
    for (int i = 0; i < 32; ++i) { const int kk = 2 * i + (lane >> 5); r_[i] = W[(size_t)(k0 + kk) * pitch + src_col0 + (lane & 31)]; g_[i] = gk ? gk[k0 + kk] : 1.f; }
#pragma unroll
    for (int i = 0; i < 32; ++i) { const int kk = 2 * i + (lane >> 5); scr[kk * 33 + (lane & 31)] = r_[i] * g_[i]; }
    asm volatile("s_waitcnt lgkmcnt(0)" ::: "memory");
    const int c = lane & 7;
#pragma unroll
    for (int j = 0; j < 4; ++j) { const int n = (lane >> 3) + 8 * j; const LAS float* s = scr + (8 * c) * 33 + n;
        u32x4 o; o.x = pk2(s[0 * 33], s[1 * 33]); o.y = pk2(s[2 * 33], s[3 * 33]); o.z = pk2(s[4 * 33], s[5 * 33]); o.w = pk2(s[6 * 33], s[7 * 33]);
        *(u32x4*)(WT + (size_t)(dst_row0 + n) * K + k0 + 8 * c) = o; }
    asm volatile("s_waitcnt lgkmcnt(0)" ::: "memory");
}
__device__ __forceinline__ void transpose_matrix(const float* W, int K, int pitch, int ncols, int gap_at, int gap, bf16_t* WT, LAS float* scr, int gw, int ngw, int lane, const float* gk = nullptr) {
    const int nblk = ncols / 32, items = (K / 64) * nblk;
    for (int it = gw; it < items; it += ngw) { const int kb = it / nblk, nb = it % nblk; const int n0 = 32 * nb;
        transpose_item(W, K, pitch, n0 + (n0 >= gap_at ? gap : 0), WT, n0, scr, kb, lane, gk); }
}

template <bool OUTF32, int GMODE, bool INBF16 = false, bool NOSTORE = false>
__device__ __forceinline__ void norm_rows(const void* src_, const float* __restrict__ g, void* dst, int rows, int gw, int ngw, int lane,
                                          const LAS float* Wg, const float* __restrict__ gbias, float* __restrict__ gate_out) {
    f32x4 gv[4];
#pragma unroll
    for (int j = 0; j < 4; ++j) gv[j] = *(const f32x4*)(g + 4 * lane + 256 * j);
    f32x4 nf[4]; u32x2 nb[4];
#define NR_LOAD(rr) do { _Pragma("unroll") for (int j = 0; j < 4; ++j) { if (INBF16) nb[j] = *(const u32x2*)((const bf16_t*)src_ + (size_t)(rr) * DM + 4 * lane + 256 * j); \
        else nf[j] = *(const f32x4*)((const float*)src_ + (size_t)(rr) * DM + 4 * lane + 256 * j); } } while (0)
    if (gw < rows) NR_LOAD(gw);
    for (int r = gw; r < rows; r += ngw) {
        f32x4 v[4]; float s = 0.f;
#pragma unroll
        for (int j = 0; j < 4; ++j) {
            if (INBF16) v[j] = (f32x4){__uint_as_float(nb[j].x << 16), __uint_as_float(nb[j].x & 0xffff0000u), __uint_as_float(nb[j].y << 16), __uint_as_float(nb[j].y & 0xffff0000u)};
            else v[j] = nf[j];
            s += (v[j].x * v[j].x + v[j].y * v[j].y) + (v[j].z * v[j].z + v[j].w * v[j].w); }
        if (r + ngw < rows) NR_LOAD(r + ngw);
        const float rstd = rsqrtf(wave_sum(s) * (1.f / DM) + EPS);
#pragma unroll
        for (int j = 0; j < 4; ++j) v[j] = v[j] * rstd * gv[j];
        if (NOSTORE) {} else if (OUTF32) { float* o = (float*)dst + (size_t)r * DM;
#pragma unroll
            for (int j = 0; j < 4; ++j) *(f32x4*)(o + 4 * lane + 256 * j) = v[j];
        } else { bf16_t* o = (bf16_t*)dst + (size_t)r * DM;
#pragma unroll
            for (int j = 0; j < 4; ++j) { u32x2 w; w.x = pk2(v[j].x, v[j].y); w.y = pk2(v[j].z, v[j].w); *(u32x2*)(o + 4 * lane + 256 * j) = w; } }
        if (GMODE != 0) {
            float myv = 0.f;
#pragma unroll
            for (int gi = 0; gi < 8; ++gi) { float d = 0.f;
#pragma unroll
                for (int j = 0; j < 4; ++j) { const f32x4 wv = *(const LAS f32x4*)(Wg + gi * 1024 + 4 * lane + 256 * j); d += (v[j].x * wv.x + v[j].y * wv.y) + (v[j].z * wv.z + v[j].w * wv.w); }
                d = wave_sum(d); if (lane == gi) myv = d; }
            if (lane < 8) { float val = myv + gbias[lane]; if (GMODE == 2) val = logsigmoidf_(val); gate_out[(size_t)r * 8 + lane] = val; }
        }
    }
}
#undef NR_LOAD
__device__ __forceinline__ void stage_gate_w(const float* __restrict__ W, int pitch, int col0, LAS float* Wg) {
    int t0 = threadIdx.x; asm volatile("" : "+v"(t0));
#pragma unroll 4
    for (int it = 0; it < 16; ++it) { const int idx = t0 + 512 * it; const int k = idx >> 3, gi = idx & 7; Wg[gi * 1024 + k] = W[(size_t)k * pitch + col0 + gi]; }
}

constexpr int LDQ = 136, LDP = 72, LDV = 72, LDC = 136, LDO = 132;
constexpr size_t WS_MS = 65536, WS_DCG = 65536 + 4096, WS_VEC = 1u << 20, WS_RS = (size_t)252 << 20;
__device__ __forceinline__ void mlstm_prescan(const float* __restrict__ gates, float* __restrict__ MS, float* __restrict__ DCG, int bh, int lane) {
    const int b = bh >> 2, h = bh & 3; float run = 0.f, pm = -INFINITY;
    const float* gp = gates + ((size_t)b * SEQ + 64 * lane) * 8;
    float ipv[64], fpv[64];
#pragma unroll
    for (int t = 0; t < 64; ++t) { ipv[t] = gp[t * 8 + h]; fpv[t] = gp[t * 8 + 4 + h]; }
#pragma unroll
    for (int t = 0; t < 64; ++t) { run += fminf(fpv[t], 0.f) - flogf_(1.f + __expf(-fabsf(fpv[t]))); pm = fmaxf(pm, ipv[t] - run); }
    float sa = run, sb_ = pm + run;
#pragma unroll
    for (int o = 1; o < 64; o <<= 1) { const float pa = __shfl_up(sa, o), pb = __shfl_up(sb_, o); if (lane >= o) { sb_ = fmaxf(pb + sa, sb_); sa = pa + sa; } }
    const float mnext = fmaxf(sa, sb_);
    float msv = __shfl_up(mnext, 1); if (lane == 0) msv = 0.f;
    const float dcv = __expf(msv - fmaxf(msv, pm));
    MS[bh * 64 + lane] = msv;
    float p = dcv; p *= __shfl_xor(p, 1); p *= __shfl_xor(p, 2); p *= __shfl_xor(p, 4);
    if ((lane & 7) == 0) DCG[bh * 8 + (lane >> 3)] = p;
}
template <bool MLSTM, bool FULL>
__device__ __forceinline__ void scan_group(LAS unsigned char* lds, int b, int h, int g, int unit, const bf16_t* __restrict__ Z, const float* __restrict__ gates,
                                           const float* __restrict__ convw, const float* __restrict__ lbl, const float* __restrict__ ng, bf16_t* __restrict__ Y,
                                           float* __restrict__ LOC, float* __restrict__ VEC, const float* __restrict__ MS, const float* __restrict__ DCG) {
    if (!FULL && g == 7) return;
    int tid = threadIdx.x; asm volatile("" : "+v"(tid)); const int lane = tid & 63, w = __builtin_amdgcn_readfirstlane(tid >> 6), fr = lane & 15, fq = lane >> 4;
    LAS bf16_t* Qs = (LAS bf16_t*)(lds + 0);
    LAS bf16_t* Ks = (LAS bf16_t*)(lds + 17408);
    LAS float* Os = (LAS float*)(lds + 0);
    LAS bf16_t* KhT = (LAS bf16_t*)(lds + 34816);
    LAS bf16_t* VT = (LAS bf16_t*)(lds + 53248);
    LAS bf16_t* Ps = (LAS bf16_t*)(lds + 71680);
    LAS bf16_t* CTb = (LAS bf16_t*)(lds + 80896);
    LAS float* F = (LAS float*)(lds + 115712);
    LAS float* rt = F; LAS float* av = F + 64; LAS float* winter = F + 128; LAS float* emt = F + 192; LAS float* wsv = F + 256; LAS float* den = F + 320;
    LAS float* nvec = F + 384; LAS float* bl = F + 512; LAS float* tot = F + 640; LAS float* misc = F + 1664;
    const unsigned* Zq = (const unsigned*)(Z + (size_t)(MLSTM ? h : 16 + h) * ZS) + lane;
    const unsigned* Zk = (const unsigned*)(Z + (size_t)(MLSTM ? 4 + h : 20 + h) * ZS) + lane;
    const unsigned* Zv = (const unsigned*)(Z + (size_t)(MLSTM ? 8 + h : 24 + h) * ZS) + lane;
    const bf16_t* Zg = Z + (size_t)(MLSTM ? 12 + h : 28 + h) * ZS;
    const int ybase = MLSTM ? (h * 128) : (512 + h * 128);
    float wq[2][4], wk[2][4]; float lb[2] = {0.f, 0.f};
    if (MLSTM) {
#pragma unroll
        for (int cc = 0; cc < 2; ++cc)
#pragma unroll
            for (int j = 0; j < 4; ++j) { wq[cc][j] = convw[j * 1024 + h * 128 + 2 * lane + cc]; wk[cc][j] = convw[j * 1024 + 512 + h * 128 + 2 * lane + cc]; }
    } else {
#pragma unroll
        for (int cc = 0; cc < 2; ++cc) { const float l0 = lbl[h * 128 + 2 * lane + cc], l1 = lbl[512 + h * 128 + 2 * lane + cc]; lb[cc] = 1.f / (1.f + __expf(l1 - l0)); } }
    f32x4 cacc[8];
#pragma unroll
    for (int i = 0; i < 8; ++i) cacc[i] = (f32x4){0.f, 0.f, 0.f, 0.f};
    float nv = 0.f, blsum[2] = {0.f, 0.f};
    if (FULL) {
        f32x4 bufA[8], bufB[8], vecA[8], vecB[8]; float nA = 0.f, nB = 0.f;
#define SG_LOAD(gp_, buf, vec, nn) do { const int up_ = unit - g + (gp_); const float* lp_ = LOC + (size_t)up_ * 16384; \
            _Pragma("unroll") for (int dt = 0; dt < 8; ++dt) { buf[dt] = *(const f32x4*)(lp_ + (size_t)(dt * 512 + tid) * 4); if (!MLSTM) vec[dt] = *(const f32x4*)(VEC + (size_t)up_ * 128 + 16 * dt + 4 * fq); } \
            if (MLSTM) nn = VEC[(size_t)up_ * 128 + (tid & 127)]; } while (0)
#define SG_COMB(gp_, buf, vec, nn) do { float dsc = 1.f; if (MLSTM) dsc = DCG[(b * 4 + h) * 8 + (gp_)]; \
            _Pragma("unroll") for (int dt = 0; dt < 8; ++dt) { f32x4 sc; if (MLSTM) sc = (f32x4){dsc, dsc, dsc, dsc}; else sc = (f32x4){__expf(vec[dt][0]), __expf(vec[dt][1]), __expf(vec[dt][2]), __expf(vec[dt][3])}; \
                cacc[dt] = cacc[dt] * sc + buf[dt]; } \
            if (MLSTM) nv = dsc * nv + nn; } while (0)
        if (g > 0) SG_LOAD(0, bufA, vecA, nA);
#pragma unroll 1
        for (int gp = 0; gp < g; gp += 2) {
            if (gp + 1 < g) SG_LOAD(gp + 1, bufB, vecB, nB);
            SG_COMB(gp, bufA, vecA, nA);
            if (gp + 1 < g) { if (gp + 2 < g) SG_LOAD(gp + 2, bufA, vecA, nA); SG_COMB(gp + 1, bufB, vecB, nB); }
        }
#undef SG_LOAD
#undef SG_COMB
#pragma unroll
        for (int dt = 0; dt < 8; ++dt) { u32x2 pkd; pkd.x = pk2(cacc[dt][0], cacc[dt][1]); pkd.y = pk2(cacc[dt][2], cacc[dt][3]);
            *(LAS u32x2*)(CTb + (16 * w + fr) * LDC + 16 * dt + 4 * fq) = pkd; }
    }
    if (tid < 128) nvec[tid] = nv;
    float m_carry = MLSTM ? MS[(b * 4 + h) * 64 + 8 * g] : 0.f;
    unsigned rk[11], rq[11], rq8[8], rv[8]; u32x4 gE0 = (u32x4){0u, 0u, 0u, 0u}, gE1 = gE0; float gi = 0.f, gf = 0.f;
#define SCAN_LOAD(cc) do { const long rb_ = (long)b * SEQ + (cc) * 64; \
        if (MLSTM) { _Pragma("unroll") for (int i = 0; i < 11; ++i) { const int r = 8 * w - 3 + i; const int pos = (cc) * 64 + r; \
                rk[i] = Zk[(rb_ + (pos >= 0 ? r : 0)) * 64]; if (FULL) rq[i] = Zq[(rb_ + (pos >= 0 ? r : 0)) * 64]; } \
            _Pragma("unroll") for (int i = 0; i < 8; ++i) rv[i] = Zv[(rb_ + 8 * w + i) * 64]; \
            if (w == 0) { gi = gates[(rb_ + lane) * 8 + h]; gf = gates[(rb_ + lane) * 8 + 4 + h]; } \
        } else { _Pragma("unroll") for (int i = 0; i < 8; ++i) { rk[i] = Zk[(rb_ + 8 * w + i) * 64]; if (FULL) rq8[i] = Zq[(rb_ + 8 * w + i) * 64]; rv[i] = Zv[(rb_ + 8 * w + i) * 64]; } } \
        } while (0)
    SCAN_LOAD(8 * g);
    __syncthreads();
#pragma unroll 1
    for (int c = 8 * g; c < 8 * g + 8; ++c) {
        const long rowbase = (long)b * SEQ + c * 64;
        float kreg[2][8];
        if (MLSTM) {
            if (c == 0 && w == 0) { rk[0] = 0u; rk[1] = 0u; rk[2] = 0u; if (FULL) { rq[0] = 0u; rq[1] = 0u; rq[2] = 0u; } }
#pragma unroll
            for (int i = 0; i < 8; ++i) { const int row = 8 * w + i;
                const float y0 = wk[0][0] * bf2f(rk[i] & 0xffffu) + wk[0][1] * bf2f(rk[i + 1] & 0xffffu) + wk[0][2] * bf2f(rk[i + 2] & 0xffffu) + wk[0][3] * bf2f(rk[i + 3] & 0xffffu);
                const float y1 = wk[1][0] * bf2f(rk[i] >> 16) + wk[1][1] * bf2f(rk[i + 1] >> 16) + wk[1][2] * bf2f(rk[i + 2] >> 16) + wk[1][3] * bf2f(rk[i + 3] >> 16);
                kreg[0][i] = siluf_(y0) * 0.08838834764831845f; kreg[1][i] = siluf_(y1) * 0.08838834764831845f;
                if (FULL) *(LAS unsigned*)(Ks + row * LDQ + 2 * lane) = pk2(kreg[0][i], kreg[1][i]); }
            { u32x4 lo, hi;
              lo.x = (rv[0] & 0xffffu) | (rv[1] << 16); lo.y = (rv[2] & 0xffffu) | (rv[3] << 16); lo.z = (rv[4] & 0xffffu) | (rv[5] << 16); lo.w = (rv[6] & 0xffffu) | (rv[7] << 16);
              hi.x = (rv[0] >> 16) | (rv[1] & 0xffff0000u); hi.y = (rv[2] >> 16) | (rv[3] & 0xffff0000u); hi.z = (rv[4] >> 16) | (rv[5] & 0xffff0000u); hi.w = (rv[6] >> 16) | (rv[7] & 0xffff0000u);
              *(LAS u32x4*)(VT + (2 * lane) * LDV + 8 * w) = lo; *(LAS u32x4*)(VT + (2 * lane + 1) * LDV + 8 * w) = hi; }
            if (FULL) {
#pragma unroll
                for (int i = 0; i < 8; ++i) {
                    const float y0 = wq[0][0] * bf2f(rq[i] & 0xffffu) + wq[0][1] * bf2f(rq[i + 1] & 0xffffu) + wq[0][2] * bf2f(rq[i + 2] & 0xffffu) + wq[0][3] * bf2f(rq[i + 3] & 0xffffu);
                    const float y1 = wq[1][0] * bf2f(rq[i] >> 16) + wq[1][1] * bf2f(rq[i + 1] >> 16) + wq[1][2] * bf2f(rq[i + 2] >> 16) + wq[1][3] * bf2f(rq[i + 3] >> 16);
                    *(LAS unsigned*)(Qs + (8 * w + i) * LDQ + 2 * lane) = pk2(siluf_(y0), siluf_(y1)); } }
            if (w == 0) {
                float bc = fminf(gf, 0.f) - flogf_(1.f + __expf(-fabsf(gf)));
#pragma unroll
                for (int o = 1; o < 64; o <<= 1) { const float t_ = __shfl_up(bc, o); if (lane >= o) bc += t_; }
                const float a_ = gi - bc; float pm = a_;
#pragma unroll
                for (int o = 1; o < 64; o <<= 1) { const float t_ = __shfl_up(pm, o); if (lane >= o) pm = fmaxf(pm, t_); }
                const float mx = fmaxf(m_carry, pm);
                rt[lane] = -mx; av[lane] = a_; winter[lane] = __expf(m_carry - mx); emt[lane] = __expf(-(bc + mx));
                const float pm63 = __shfl(pm, 63), bl63 = __shfl(bc, 63);
                const float mx63 = fmaxf(m_carry, pm63);
                wsv[lane] = __expf(a_ - mx63);
                if (lane == 0) misc[0] = __expf(m_carry - mx63);
                m_carry = bl63 + mx63;
            }
        } else {
            float lc[2][8], qs[2][8], vs[2][8]; float run[2] = {0.f, 0.f};
#pragma unroll
            for (int i = 0; i < 8; ++i)
#pragma unroll
                for (int cc = 0; cc < 2; ++cc) {
                    const float zf = bf2f(cc ? (rk[i] >> 16) : (rk[i] & 0xffffu));
                    const float sg = rcpf_(1.f + __expf(-zf)), sgn = rcpf_(1.f + __expf(zf));
                    const float f = lb[cc] + (1.f - lb[cc]) * sg; run[cc] += flogf_(f); lc[cc][i] = run[cc]; kreg[cc][i] = (1.f - lb[cc]) * sgn;
                    if (FULL) qs[cc][i] = siluf_(bf2f(cc ? (rq8[i] >> 16) : (rq8[i] & 0xffffu)));
                    vs[cc][i] = siluf_(bf2f(cc ? (rv[i] >> 16) : (rv[i] & 0xffffu))); }
#pragma unroll
            for (int cc = 0; cc < 2; ++cc) { u32x4 vv; vv.x = pk2(vs[cc][0], vs[cc][1]); vv.y = pk2(vs[cc][2], vs[cc][3]); vv.z = pk2(vs[cc][4], vs[cc][5]); vv.w = pk2(vs[cc][6], vs[cc][7]);
                *(LAS u32x4*)(VT + (2 * lane + cc) * LDV + 8 * w) = vv; }
            *(LAS f32x2_t*)(tot + w * 128 + 2 * lane) = (f32x2_t){run[0], run[1]};
            LBAR();
            float prefix[2] = {0.f, 0.f}, total[2] = {0.f, 0.f};
#pragma unroll
            for (int p_ = 0; p_ < 8; ++p_) { const f32x2_t tv = *(const LAS f32x2_t*)(tot + p_ * 128 + 2 * lane); total[0] += tv.x; total[1] += tv.y; if (p_ < w) { prefix[0] += tv.x; prefix[1] += tv.y; } }
            blsum[0] += total[0]; blsum[1] += total[1];
            float kh[2][8];
#pragma unroll
            for (int i = 0; i < 8; ++i) { const int row = 8 * w + i; const float b0 = prefix[0] + lc[0][i], b1 = prefix[1] + lc[1][i];
                if (FULL) { *(LAS unsigned*)(Qs + row * LDQ + 2 * lane) = pk2(qs[0][i] * __expf(b0), qs[1][i] * __expf(b1));
                            *(LAS unsigned*)(Ks + row * LDQ + 2 * lane) = pk2(kreg[0][i] * __expf(-b0), kreg[1][i] * __expf(-b1)); }
                kh[0][i] = kreg[0][i] * __expf(total[0] - b0); kh[1][i] = kreg[1][i] * __expf(total[1] - b1); }
#pragma unroll
            for (int cc = 0; cc < 2; ++cc) { u32x4 kk4; kk4.x = pk2(kh[cc][0], kh[cc][1]); kk4.y = pk2(kh[cc][2], kh[cc][3]); kk4.z = pk2(kh[cc][4], kh[cc][5]); kk4.w = pk2(kh[cc][6], kh[cc][7]);
                *(LAS u32x4*)(KhT + (2 * lane + cc) * LDV + 8 * w) = kk4; }
            if (w == 0) *(LAS f32x2_t*)(bl + 2 * lane) = (f32x2_t){__expf(total[0]), __expf(total[1])};
        }
        if (c + 1 < 8 * g + 8) SCAN_LOAD(c + 1);
        LBAR();
        if (FULL) { const bf16_t* gp_ = Zg + (rowbase + (tid >> 3)) * 128 + 16 * (tid & 7); gE0 = *(const u32x4*)gp_; gE1 = *(const u32x4*)(gp_ + 8); }
        if (MLSTM) { const f32x4 w0 = *(const LAS f32x4*)(wsv + 8 * w), w1 = *(const LAS f32x4*)(wsv + 8 * w + 4);
#pragma unroll
            for (int cc = 0; cc < 2; ++cc) { u32x4 kk4; kk4.x = pk2(kreg[cc][0] * w0[0], kreg[cc][1] * w0[1]); kk4.y = pk2(kreg[cc][2] * w0[2], kreg[cc][3] * w0[3]);
                kk4.z = pk2(kreg[cc][4] * w1[0], kreg[cc][5] * w1[1]); kk4.w = pk2(kreg[cc][6] * w1[2], kreg[cc][7] * w1[3]);
                *(LAS u32x4*)(KhT + (2 * lane + cc) * LDV + 8 * w) = kk4; } }
        if (FULL) { const int tt = w >> 1, st0 = 2 * (w & 1);
            f32x4 s_[2] = {(f32x4){0.f, 0.f, 0.f, 0.f}, (f32x4){0.f, 0.f, 0.f, 0.f}};
#pragma unroll
            for (int kk = 0; kk < 4; ++kk) { const bf16x8 a = ldf(Qs + (16 * tt + fr) * LDQ + 32 * kk + 8 * fq);
#pragma unroll
                for (int i = 0; i < 2; ++i) { const bf16x8 bb = ldf(Ks + (16 * (st0 + i) + fr) * LDQ + 32 * kk + 8 * fq); s_[i] = MFMA16(a, bb, s_[i]); } }
#pragma unroll
            for (int i = 0; i < 2; ++i) { const int si = 16 * (st0 + i) + fr;
#pragma unroll
                for (int j = 0; j < 4; ++j) { const int t_ = 16 * tt + 4 * fq + j; float pv = 0.f;
                    if (si <= t_) pv = MLSTM ? s_[i][j] * __expf(rt[t_] + av[si]) : s_[i][j];
                    Ps[t_ * LDP + si] = (bf16_t)f2bf(pv); } } }
        if (FULL || MLSTM) LBAR();
        if (FULL && MLSTM) { const int t_ = tid >> 3, sub = tid & 7; float s8 = 0.f, qn = 0.f;
#pragma unroll
            for (int i = 0; i < 8; ++i) s8 += bf2f(Ps[t_ * LDP + 8 * sub + i]);
#pragma unroll
            for (int i = 0; i < 16; ++i) qn += bf2f(Qs[t_ * LDQ + 16 * sub + i]) * nvec[16 * sub + i];
            float val = s8 + winter[t_] * qn; val += __shfl_xor(val, 1); val += __shfl_xor(val, 2); val += __shfl_xor(val, 4);
            if (sub == 0) den[t_] = val; }
        f32x4 oacc[4];
        { bf16x8 vb[2]; vb[0] = ldf(VT + (16 * w + fr) * LDV + 8 * fq); vb[1] = ldf(VT + (16 * w + fr) * LDV + 32 + 8 * fq);
            if (FULL) { bf16x8 cb[4];
#pragma unroll
                for (int kk = 0; kk < 4; ++kk) cb[kk] = ldf(CTb + (16 * w + fr) * LDC + 32 * kk + 8 * fq);
#pragma unroll
                for (int tt = 0; tt < 4; ++tt) { f32x4 a1 = (f32x4){0.f, 0.f, 0.f, 0.f}, a2 = (f32x4){0.f, 0.f, 0.f, 0.f};
#pragma unroll
                    for (int kk = 0; kk < 2; ++kk) a1 = MFMA16(ldf(Ps + (16 * tt + fr) * LDP + 32 * kk + 8 * fq), vb[kk], a1);
#pragma unroll
                    for (int kk = 0; kk < 4; ++kk) a2 = MFMA16(ldf(Qs + (16 * tt + fr) * LDQ + 32 * kk + 8 * fq), cb[kk], a2);
                    if (MLSTM) { const f32x4 wi = *(const LAS f32x4*)(winter + 16 * tt + 4 * fq); oacc[tt] = a1 + wi * a2; } else oacc[tt] = a1 + a2;
                    __builtin_amdgcn_sched_barrier(0); } }
            const float dec = MLSTM ? misc[0] : 0.f;
            { bf16x8 kfr[2][2];
#pragma unroll
              for (int kk = 0; kk < 2; ++kk) kfr[0][kk] = ldf(KhT + fr * LDV + 32 * kk + 8 * fq);
#pragma unroll
              for (int dt = 0; dt < 8; ++dt) {
                if (dt < 7) {
#pragma unroll
                    for (int kk = 0; kk < 2; ++kk) kfr[(dt + 1) & 1][kk] = ldf(KhT + (16 * (dt + 1) + fr) * LDV + 32 * kk + 8 * fq); }
                f32x4 sc; if (MLSTM) sc = (f32x4){dec, dec, dec, dec}; else sc = *(const LAS f32x4*)(bl + 16 * dt + 4 * fq);
                __builtin_amdgcn_sched_barrier(0);
                f32x4 a = cacc[dt] * sc;
#pragma unroll
                for (int kk = 0; kk < 2; ++kk) a = MFMA16(kfr[dt & 1][kk], vb[kk], a);
                cacc[dt] = a; __builtin_amdgcn_sched_barrier(0); } } }
        if (FULL) LBAR();
        if (FULL) {
#pragma unroll
            for (int tt = 0; tt < 4; ++tt)
#pragma unroll
                for (int j = 0; j < 4; ++j) Os[(16 * tt + 4 * fq + j) * LDO + 16 * w + fr] = oacc[tt][j];
#pragma unroll
            for (int dt = 0; dt < 8; ++dt) { u32x2 pkd; pkd.x = pk2(cacc[dt][0], cacc[dt][1]); pkd.y = pk2(cacc[dt][2], cacc[dt][3]);
                *(LAS u32x2*)(CTb + (16 * w + fr) * LDC + 16 * dt + 4 * fq) = pkd; } }
        if (MLSTM && tid < 128) { float sm = 0.f;
#pragma unroll
            for (int i = 0; i < 8; ++i) { const u32x4 kk4 = *(const LAS u32x4*)(KhT + tid * LDV + 8 * i);
                sm += (bf2f((unsigned short)(kk4.x & 0xffffu)) + bf2f((unsigned short)(kk4.x >> 16))) + (bf2f((unsigned short)(kk4.y & 0xffffu)) + bf2f((unsigned short)(kk4.y >> 16)))
                    + (bf2f((unsigned short)(kk4.z & 0xffffu)) + bf2f((unsigned short)(kk4.z >> 16))) + (bf2f((unsigned short)(kk4.w & 0xffffu)) + bf2f((unsigned short)(kk4.w >> 16))); }
            nvec[tid] = misc[0] * nvec[tid] + sm; }
        LBAR();
        if (FULL) { const int t_ = tid >> 3, sub = tid & 7;
            const unsigned gw_[8] = {gE0.x, gE0.y, gE0.z, gE0.w, gE1.x, gE1.y, gE1.z, gE1.w};
            float o[16]; float inv = 1.f;
            if (MLSTM) inv = rcpf_(fmaxf(fabsf(den[t_]), emt[t_]));
            float ss = 0.f;
#pragma unroll
            for (int i = 0; i < 16; ++i) { const float gv_ = bf2f((unsigned short)((i & 1) ? (gw_[i >> 1] >> 16) : (gw_[i >> 1] & 0xffffu)));
                float x = Os[t_ * LDO + 16 * sub + i];
                if (MLSTM) x = x * inv * sigmoidf_(gv_);
                o[i] = x; ss += x * x;
                if (!MLSTM) o[i] = x * siluf_(gv_); }
            ss += __shfl_xor(ss, 1); ss += __shfl_xor(ss, 2); ss += __shfl_xor(ss, 4);
            const float rstd = rsqrtf(ss * (1.f / 128.f) + EPS);
            unsigned op[8];
#pragma unroll
            for (int i = 0; i < 8; ++i) op[i] = pk2(o[2 * i] * rstd * ng[h * 128 + 16 * sub + 2 * i], o[2 * i + 1] * rstd * ng[h * 128 + 16 * sub + 2 * i + 1]);
            bf16_t* yp = Y + (rowbase + t_) * DM + ybase + 16 * sub;
            *(u32x4*)yp = (u32x4){op[0], op[1], op[2], op[3]}; *(u32x4*)(yp + 8) = (u32x4){op[4], op[5], op[6], op[7]};
            LBAR();
        }
    }
#undef SCAN_LOAD
    if (!FULL) {
        float* lp = LOC + (size_t)unit * 16384;
#pragma unroll
        for (int dt = 0; dt < 8; ++dt) *(f32x4*)(lp + (size_t)(dt * 512 + tid) * 4) = cacc[dt];
        if (MLSTM) { if (tid < 128) VEC[(size_t)unit * 128 + tid] = nvec[tid]; }
        else if (w == 0) { VEC[(size_t)unit * 128 + 2 * lane] = blsum[0]; VEC[(size_t)unit * 128 + 2 * lane + 1] = blsum[1]; }
    }
}

__device__ __forceinline__ int pcol(int key) { return 32 * (key >> 5) + 8 * ((key >> 2) & 3) + 4 * ((key >> 4) & 1) + (key & 3); }
__device__ __forceinline__ float ex2(float x) { return __builtin_amdgcn_exp2f(x); }

__device__ __forceinline__ int pcol256(int key) { return (key & ~63) | pcol(key & 63); }
__device__ __forceinline__ void xattn_vt_prep(const bf16_t* __restrict__ KV, bf16_t* __restrict__ Vt, int gid) {
    const int e8 = gid & 31, hx = (gid >> 5) & 3, key = (gid >> 7) & 255, b = gid >> 15;
    const u32x4 vv = *(const u32x4*)(KV + (size_t)(b * 256 + key) * 2048 + 1024 + hx * 256 + 8 * e8); const unsigned vw[4] = {vv.x, vv.y, vv.z, vv.w};
    bf16_t* dst = Vt + ((size_t)(b * 4 + hx) * 256 + 8 * e8) * 256 + pcol256(key);
#pragma unroll
    for (int e = 0; e < 8; ++e) dst[e * 256] = (bf16_t)((e & 1) ? (vw[e >> 1] >> 16) : (vw[e >> 1] & 0xffffu));
}
__device__ __forceinline__ void xattn_phase(LAS unsigned char* lds, const bf16_t* __restrict__ Q, const bf16_t* __restrict__ KV, const bf16_t* __restrict__ Vt, bf16_t* __restrict__ O, int rb0, int hx) {
    constexpr int KBUF = 32768, XBUF = 65536;
    int tid = threadIdx.x; asm volatile("" : "+v"(tid)); const int lane = tid & 63, w = __builtin_amdgcn_readfirstlane(tid >> 6), fr = lane & 15, fq = lane >> 4;
    const int ka0 = (fr >> 1) * 1024 + (fr & 1) * 512 + ((fq ^ (fr & 3)) << 4), kx = fr >> 2;
    const int va0 = KBUF + fr * 128;
#pragma unroll 1
    for (int rb = rb0; rb < rb0 + 2; ++rb) {
        const int row0 = rb * 128 + 16 * w; const int b = (rb * 128) / SEQ;
#define XA_DMA(kt_, buf_) do { \
            _Pragma("unroll") for (int i = 0; i < 4; ++i) { const int j = 4 * w + i; const int row = 2 * j + (lane >> 5); const int c = (lane & 31) ^ (row & 15); \
                __builtin_amdgcn_global_load_lds((const unsigned*)(KV + (size_t)(b * 256 + 64 * (kt_) + row) * 2048 + hx * 256 + 8 * c), (LAS unsigned*)(lds + (buf_) * XBUF + j * 1024), 16, 0, 0); } \
            _Pragma("unroll") for (int i = 0; i < 4; ++i) { const int j = 4 * w + i; const int row = 8 * j + (lane >> 3); const int c = (lane & 7) ^ ((row >> 1) & 7); \
                __builtin_amdgcn_global_load_lds((const unsigned*)(Vt + ((size_t)(b * 4 + hx) * 256 + row) * 256 + 64 * (kt_) + 8 * c), (LAS unsigned*)(lds + (buf_) * XBUF + KBUF + j * 1024), 16, 0, 0); } } while (0)
        XA_DMA(0, 0);
        bf16x8 qf[8];
#pragma unroll
        for (int kk = 0; kk < 8; ++kk) qf[kk] = *(const bf16x8*)(Q + (size_t)(row0 + fr) * DM + hx * 256 + 32 * kk + 8 * fq);
        f32x4 ot[16];
#pragma unroll
        for (int i = 0; i < 16; ++i) ot[i] = (f32x4){0.f, 0.f, 0.f, 0.f};
        float mrun = -INFINITY, lrun = 0.f;
        asm volatile("s_waitcnt vmcnt(0)" ::: "memory");
        LBAR();
        for (int kt = 0; kt < 4; ++kt) {
            if (kt + 1 < 4) XA_DMA(kt + 1, (kt + 1) & 1);
            const LAS unsigned char* Kb = lds + (kt & 1) * XBUF;
            f32x4 st[4];
            { bf16x8 kfr[2][4];
#pragma unroll
              for (int kk = 0; kk < 4; ++kk) kfr[0][kk] = *(const LAS bf16x8*)(Kb + ka0 + ((kk ^ kx) << 6));
#pragma unroll
              for (int hb = 0; hb < 8; ++hb) { const int k16 = hb >> 1, k0 = 4 * (hb & 1);
                if (hb < 7) { const int n16 = (hb + 1) >> 1, n0 = 4 * ((hb + 1) & 1);
#pragma unroll
                    for (int kk = 0; kk < 4; ++kk) kfr[(hb + 1) & 1][kk] = *(const LAS bf16x8*)(Kb + n16 * 8192 + ka0 + (((n0 + kk) ^ kx) << 6)); }
                __builtin_amdgcn_sched_barrier(0);
                f32x4 a = (hb & 1) ? st[k16] : (f32x4){0.f, 0.f, 0.f, 0.f};
#pragma unroll
                for (int kk = 0; kk < 4; ++kk) a = MFMA16(kfr[hb & 1][kk], qf[k0 + kk], a);
                st[k16] = a; __builtin_amdgcn_sched_barrier(0); } }
            float mx = -INFINITY;
#pragma unroll
            for (int k16 = 0; k16 < 4; ++k16)
#pragma unroll
                for (int j = 0; j < 4; ++j) mx = fmaxf(mx, st[k16][j]);
            mx = fmaxf(mx, __shfl_xor(mx, 16)); mx = fmaxf(mx, __shfl_xor(mx, 32));
            const bool resc = (kt == 0) || __any(mx > mrun + 8.f);
            float alpha = 1.f;
            if (resc) { const float mnew = (kt == 0) ? mx : fmaxf(mrun, mx); alpha = (kt == 0) ? 1.f : ex2(mrun - mnew); mrun = mnew; }
            float ps = 0.f;
#pragma unroll
            for (int k16 = 0; k16 < 4; ++k16)
#pragma unroll
                for (int j = 0; j < 4; ++j) { const float p = ex2(st[k16][j] - mrun); st[k16][j] = p; ps += p; }
            lrun = lrun * alpha + ps;
            bf16x8 pf[2];
#pragma unroll
            for (int kb = 0; kb < 2; ++kb) { u32x4 pw; pw.x = pk2(st[2 * kb][0], st[2 * kb][1]); pw.y = pk2(st[2 * kb][2], st[2 * kb][3]); pw.z = pk2(st[2 * kb + 1][0], st[2 * kb + 1][1]); pw.w = pk2(st[2 * kb + 1][2], st[2 * kb + 1][3]);
                pf[kb] = __builtin_bit_cast(bf16x8, pw); }
            { bf16x8 vfr[2][2];
#pragma unroll
              for (int kb = 0; kb < 2; ++kb) vfr[0][kb] = *(const LAS bf16x8*)(Kb + va0 + (((4 * kb + fq) ^ (fr >> 1)) << 4));
#pragma unroll
              for (int et = 0; et < 16; ++et) {
                if (et < 15) {
#pragma unroll
                    for (int kb = 0; kb < 2; ++kb) vfr[(et + 1) & 1][kb] = *(const LAS bf16x8*)(Kb + (et + 1) * 2048 + va0 + (((4 * kb + fq) ^ (fr >> 1)) << 4)); }
                __builtin_amdgcn_sched_barrier(0);
                f32x4 a = ot[et]; if (resc) a = a * alpha;
#pragma unroll
                for (int kb = 0; kb < 2; ++kb) a = MFMA16(vfr[et & 1][kb], pf[kb], a);
                ot[et] = a; __builtin_amdgcn_sched_barrier(0); } }
            asm volatile("s_waitcnt vmcnt(0)" ::: "memory");
            LBAR();
        }
#undef XA_DMA
        lrun += __shfl_xor(lrun, 16); lrun += __shfl_xor(lrun, 32);
        const float inv = 1.f / lrun;
        bf16_t* op = O + (size_t)(row0 + fr) * DM + hx * 256 + 4 * fq;
#pragma unroll
        for (int et = 0; et < 16; ++et) { u32x2 wv; wv.x = pk2(ot[et][0] * inv, ot[et][1] * inv); wv.y = pk2(ot[et][2] * inv, ot[et][3] * inv); *(u32x2*)(op + 16 * et) = wv; }
    }
}

__device__ __forceinline__ void fox_prep(bf16_t* Z, const float* __restrict__ gq, const float* __restrict__ gk, int gw, int ngw, int lane) {
    const int e0 = 8 * (lane & 15);
    for (int task = gw; task < 16 * (T / 4); task += ngw) { const int slot = task / (T / 4), row = 4 * (task % (T / 4)) + (lane >> 4);
        bf16_t* p = Z + (size_t)slot * ZS + (size_t)row * 128 + e0;
        const u32x4 raw = *(const u32x4*)p; const unsigned rw[4] = {raw.x, raw.y, raw.z, raw.w};
        float x[8]; float ss = 0.f;
#pragma unroll
        for (int i = 0; i < 8; ++i) { x[i] = bf2f((unsigned short)((i & 1) ? (rw[i >> 1] >> 16) : (rw[i >> 1] & 0xffffu))); ss += x[i] * x[i]; }
        ss += __shfl_xor(ss, 1); ss += __shfl_xor(ss, 2); ss += __shfl_xor(ss, 4); ss += __shfl_xor(ss, 8);
        float sc = rsqrtf(ss * (1.f / 128.f) + EPS); const float* g = (slot < 8) ? gq : gk; if (slot < 8) sc *= 0.08838834764831845f * LOG2E;
        u32x4 o; o.x = pk2(x[0] * sc * g[e0], x[1] * sc * g[e0 + 1]); o.y = pk2(x[2] * sc * g[e0 + 2], x[3] * sc * g[e0 + 3]);
        o.z = pk2(x[4] * sc * g[e0 + 4], x[5] * sc * g[e0 + 5]); o.w = pk2(x[6] * sc * g[e0 + 6], x[7] * sc * g[e0 + 7]);
        *(u32x4*)p = o; }
}
__device__ __forceinline__ void fox_cumsum(const float* __restrict__ FG, float* __restrict__ CUM, int bh, int lane) {
    const int b = bh >> 3, h = bh & 7; float v[64]; float run = 0.f;
    const float* p = FG + ((size_t)b * SEQ + 64 * lane) * 8 + h;
#pragma unroll
    for (int i = 0; i < 64; ++i) v[i] = p[i * 8];
#pragma unroll
    for (int i = 0; i < 64; ++i) { run += v[i]; v[i] = run; }
    float inc = run;
#pragma unroll
    for (int o = 1; o < 64; o <<= 1) { const float t_ = __shfl_up(inc, o); if (lane >= o) inc += t_; }
    const float base = inc - run; float* q = CUM + (size_t)bh * SEQ + 64 * lane;
#pragma unroll
    for (int i = 0; i < 16; ++i) *(f32x4*)(q + 4 * i) = (f32x4){base + v[4 * i], base + v[4 * i + 1], base + v[4 * i + 2], base + v[4 * i + 3]};
}

__device__ __forceinline__ void fox_cumsum_lds(LAS unsigned char* lds, const float* __restrict__ FG, int b, int h) {
    int tid = threadIdx.x; asm volatile("" : "+v"(tid)); const int lane = tid & 63, w = __builtin_amdgcn_readfirstlane(tid >> 6);
    LAS float* cumL = (LAS float*)(lds + 66560); LAS float* wtot = (LAS float*)(lds + 66560 + 16384);
    float v[8]; const float* p = FG + ((size_t)b * SEQ + 512 * w + 8 * lane) * 8 + h;
#pragma unroll
    for (int i = 0; i < 8; ++i) v[i] = p[i * 8];
    float run = 0.f;
#pragma unroll
    for (int i = 0; i < 8; ++i) { run += v[i]; v[i] = run; }
    float inc = run;
#pragma unroll
    for (int o = 1; o < 64; o <<= 1) { const float t_ = __shfl_up(inc, o); if (lane >= o) inc += t_; }
    if (lane == 63) wtot[w] = inc;
    LBAR();
    float base = inc - run;
    for (int w2 = 0; w2 < w; ++w2) base += wtot[w2];
#pragma unroll
    for (int i = 0; i < 8; ++i) cumL[512 * w + 8 * lane + i] = base + v[i];
    LBAR();
}
__device__ __forceinline__ void fox_unit(LAS unsigned char* lds, int b, int h, int qb, const bf16_t* __restrict__ Z, const bf16_t* __restrict__ VTg, bf16_t* __restrict__ O) {
    int tid = threadIdx.x; asm volatile("" : "+v"(tid)); const int lane = tid & 63, w = __builtin_amdgcn_readfirstlane(tid >> 6), fr = lane & 15, fq = lane >> 4;
    const LAS float* cum = (const LAS float*)(lds + 66560);
    const int q0 = qb * 256; const long rowb = (long)b * SEQ;
    const float cref = cum[q0];
    bf16x8 qf[2][4]; float cqs[2]; int qpos[2];
#pragma unroll
    for (int qt = 0; qt < 2; ++qt) { qpos[qt] = q0 + 32 * w + 16 * qt + fr; cqs[qt] = (cum[qpos[qt]] - cref) * LOG2E;
#pragma unroll
        for (int kk = 0; kk < 4; ++kk) qf[qt][kk] = *(const bf16x8*)(Z + (size_t)h * ZS + (size_t)(rowb + qpos[qt]) * 128 + 32 * kk + 8 * fq); }
    f32x4 ot[2][8];
#pragma unroll
    for (int qt = 0; qt < 2; ++qt)
#pragma unroll
        for (int i = 0; i < 8; ++i) ot[qt][i] = (f32x4){0.f, 0.f, 0.f, 0.f};
    float mrun[2] = {0.f, 0.f}, lrun[2] = {0.f, 0.f};
    const int ntile = 4 * qb + 4; const int wmax = q0 + 32 * w + 31;
    constexpr int KB_ = 16384, BUFB = 32768 + 256;
    const bf16_t* Kg = Z + (size_t)(8 + h) * ZS + (size_t)rowb * 128;
    const bf16_t* Vg = VTg + (size_t)(b * 8 + h) * 128 * SEQ;
    float cr = 0.f;
#define FOX_DMA(kt_, buf_) do { \
        _Pragma("unroll") for (int i = 0; i < 2; ++i) { const int j = 2 * w + i; const int row = 4 * j + (lane >> 4); const int c = (lane & 15) ^ (row & 15); \
            __builtin_amdgcn_global_load_lds((const unsigned*)(Kg + (size_t)(64 * (kt_) + row) * 128 + 8 * c), (LAS unsigned*)(lds + (buf_) * BUFB + j * 1024), 16, 0, 0); } \
        _Pragma("unroll") for (int i = 0; i < 2; ++i) { const int j = 2 * w + i; const int row = 8 * j + (lane >> 3); const int c = (lane & 7) ^ ((row >> 1) & 7); \
            __builtin_amdgcn_global_load_lds((const unsigned*)(Vg + (size_t)row * SEQ + 64 * (kt_) + 8 * c), (LAS unsigned*)(lds + (buf_) * BUFB + KB_ + j * 1024), 16, 0, 0); } \
        cr = cum[64 * (kt_) + lane]; } while (0)
#define FOX_CKS(buf_) do { if (tid < 64) ((LAS float*)(lds + (buf_) * BUFB + 32768))[tid] = (cr - cref) * LOG2E; } while (0)
    const int ka0 = fr * 256, va0 = KB_ + fr * 128;
    FOX_DMA(0, 0); FOX_CKS(0);
    asm volatile("s_waitcnt vmcnt(0)" ::: "memory");
    LBAR();
    for (int kt = 0; kt < ntile; ++kt) {
        const LAS unsigned char* Kb = lds + (kt & 1) * BUFB; const LAS float* cks = (const LAS float*)(Kb + 32768);
        if (kt + 1 < ntile) FOX_DMA(kt + 1, (kt + 1) & 1);
        if (64 * kt <= wmax) {
            const bool band = (64 * kt + 63 > q0 + 32 * w);
            f32x4 st[2][4]; const float cm0 = cqs[0] - mrun[0], cm1 = cqs[1] - mrun[1];
            bf16x8 kfr[2][4]; f32x4 ckr[2];
#pragma unroll
            for (int kk = 0; kk < 4; ++kk) kfr[0][kk] = *(const LAS bf16x8*)(Kb + ka0 + (((4 * kk + fq) ^ fr) << 4));
            ckr[0] = *(const LAS f32x4*)(cks + 4 * fq);
#pragma unroll
            for (int k16 = 0; k16 < 4; ++k16) {
                if (k16 < 3) {
#pragma unroll
                    for (int kk = 0; kk < 4; ++kk) kfr[(k16 + 1) & 1][kk] = *(const LAS bf16x8*)(Kb + (k16 + 1) * 4096 + ka0 + (((4 * kk + fq) ^ fr) << 4));
                    ckr[(k16 + 1) & 1] = *(const LAS f32x4*)(cks + 16 * (k16 + 1) + 4 * fq); }
                __builtin_amdgcn_sched_barrier(0);
                f32x4 a0 = cm0 - ckr[k16 & 1], a1 = cm1 - ckr[k16 & 1];
#pragma unroll
                for (int kk = 0; kk < 4; ++kk) { a0 = MFMA16(kfr[k16 & 1][kk], qf[0][kk], a0); a1 = MFMA16(kfr[k16 & 1][kk], qf[1][kk], a1); }
                st[0][k16] = a0; st[1][k16] = a1; }
            if (band) {
#pragma unroll
                for (int qt = 0; qt < 2; ++qt)
#pragma unroll
                    for (int k16 = 0; k16 < 4; ++k16)
#pragma unroll
                        for (int j = 0; j < 4; ++j) if (64 * kt + 16 * k16 + 4 * fq + j > qpos[qt]) st[qt][k16][j] = -INFINITY; }
            float mx[2];
#pragma unroll
            for (int qt = 0; qt < 2; ++qt) { float m_ = -INFINITY;
#pragma unroll
                for (int k16 = 0; k16 < 4; ++k16)
#pragma unroll
                    for (int j = 0; j < 4; ++j) m_ = fmaxf(m_, st[qt][k16][j]);
                m_ = fmaxf(m_, __shfl_xor(m_, 16)); m_ = fmaxf(m_, __shfl_xor(m_, 32)); mx[qt] = m_; }
            const bool first = (kt == 0);
            if (first || __any((mx[0] > 8.f) || (mx[1] > 8.f))) {
#pragma unroll
                for (int qt = 0; qt < 2; ++qt) { const float delta = first ? mx[qt] : fmaxf(mx[qt], 0.f); const float alpha = first ? 1.f : ex2(-delta); mrun[qt] += delta;
                    lrun[qt] *= alpha;
#pragma unroll
                    for (int et = 0; et < 8; ++et) ot[qt][et] = ot[qt][et] * alpha;
#pragma unroll
                    for (int k16 = 0; k16 < 4; ++k16) st[qt][k16] = st[qt][k16] - delta; } }
#pragma unroll
            for (int qt = 0; qt < 2; ++qt) { float ps = 0.f;
#pragma unroll
                for (int k16 = 0; k16 < 4; ++k16)
#pragma unroll
                    for (int j = 0; j < 4; ++j) { const float p = ex2(st[qt][k16][j]); st[qt][k16][j] = p; ps += p; }
                lrun[qt] += ps; }
            bf16x8 pf[2][2];
#pragma unroll
            for (int qt = 0; qt < 2; ++qt)
#pragma unroll
                for (int kb = 0; kb < 2; ++kb) { u32x4 pw; pw.x = pk2(st[qt][2 * kb][0], st[qt][2 * kb][1]); pw.y = pk2(st[qt][2 * kb][2], st[qt][2 * kb][3]);
                    pw.z = pk2(st[qt][2 * kb + 1][0], st[qt][2 * kb + 1][1]); pw.w = pk2(st[qt][2 * kb + 1][2], st[qt][2 * kb + 1][3]); pf[qt][kb] = __builtin_bit_cast(bf16x8, pw); }
            { bf16x8 vfr[2][2];
#pragma unroll
              for (int kb = 0; kb < 2; ++kb) vfr[0][kb] = *(const LAS bf16x8*)(Kb + va0 + (((4 * kb + fq) ^ (fr >> 1)) << 4));
#pragma unroll
              for (int et = 0; et < 8; ++et) {
                if (et < 7) {
#pragma unroll
                    for (int kb = 0; kb < 2; ++kb) vfr[(et + 1) & 1][kb] = *(const LAS bf16x8*)(Kb + (et + 1) * 2048 + va0 + (((4 * kb + fq) ^ (fr >> 1)) << 4)); }
                __builtin_amdgcn_sched_barrier(0);
#pragma unroll
                for (int kb = 0; kb < 2; ++kb) { ot[0][et] = MFMA16(vfr[et & 1][kb], pf[0][kb], ot[0][et]); ot[1][et] = MFMA16(vfr[et & 1][kb], pf[1][kb], ot[1][et]); } } }
        }
        if (kt + 1 < ntile) FOX_CKS((kt + 1) & 1);
        asm volatile("s_waitcnt vmcnt(0)" ::: "memory");
        LBAR();
    }
#undef FOX_DMA
#undef FOX_CKS
#pragma unroll
    for (int qt = 0; qt < 2; ++qt) { float l = lrun[qt]; l += __shfl_xor(l, 16); l += __shfl_xor(l, 32); const float inv = 1.f / l;
        const bf16_t* gp = Z + (size_t)(24 + h) * ZS + (size_t)(rowb + qpos[qt]) * 128 + 4 * fq;
        bf16_t* op = O + (size_t)(rowb + qpos[qt]) * DM + h * 128 + 4 * fq;
#pragma unroll
        for (int et = 0; et < 8; ++et) { const u32x2 gr = *(const u32x2*)(gp + 16 * et);
            const float g0 = sigmoidf_(bf2f((unsigned short)(gr.x & 0xffffu))), g1 = sigmoidf_(bf2f((unsigned short)(gr.x >> 16))), g2 = sigmoidf_(bf2f((unsigned short)(gr.y & 0xffffu))), g3 = sigmoidf_(bf2f((unsigned short)(gr.y >> 16)));
            u32x2 wv; wv.x = pk2(ot[qt][et][0] * inv * g0, ot[qt][et][1] * inv * g1); wv.y = pk2(ot[qt][et][2] * inv * g2, ot[qt][et][3] * inv * g3); *(u32x2*)(op + 16 * et) = wv; } }
}

#define XB_TMO      128
#define XB_XCNT(j)  (256  + 64 * (j))
#define XB_XSUB(j)  (1280 + 64 * (j))
#define XB_XGEN(j)  (2304 + 64 * (j))
#define XB_TOP      3328
#define XB_TOPGEN   3392
#define XCD_BAR_WORDS 3456
#define XB_SPIN_CAP (1u << 18)

__device__ __forceinline__ unsigned xb_ld(unsigned* p)              { return __hip_atomic_load(p, __ATOMIC_RELAXED, __HIP_MEMORY_SCOPE_AGENT); }
__device__ __forceinline__ unsigned xb_add(unsigned* p, unsigned v) { return __hip_atomic_fetch_add(p, v, __ATOMIC_RELAXED, __HIP_MEMORY_SCOPE_AGENT); }
__device__ __forceinline__ unsigned xb_xcc_id() { return (unsigned)__builtin_amdgcn_s_getreg((3 << 11) | 20) & 0xFu; }
#define XB_SPIN(cond, bar) do { unsigned _sp = 0; while (cond) { __builtin_amdgcn_s_sleep(1); \
    if ((++_sp & 255u) == 0u) { if (xb_ld(&(bar)[XB_TMO])) break; if (_sp > XB_SPIN_CAP) { atomicAdd(&(bar)[XB_TMO], 1u); break; } } } } while (0)

struct XcdBarrier {
    unsigned* bar; unsigned x;
    volatile LAS unsigned* st;
};

__device__ __forceinline__ XcdBarrier xcd_barrier_post(unsigned* bar, volatile LAS unsigned* st) {
    XcdBarrier b; b.bar = bar; b.x = xb_xcc_id(); b.st = st;
    if (threadIdx.x == 0) (void)xb_add(&bar[XB_XCNT(b.x)], 1u);
    return b;
}
__device__ __forceinline__ void xcd_barrier_complete(unsigned* bar, unsigned x, unsigned& nloc, unsigned& nx) {
    const unsigned G = gridDim.x * gridDim.y * gridDim.z;
    unsigned sum, cnt, mine, sp = 0u;
    for (;;) {
        sum = 0u; cnt = 0u; mine = 0u;
#pragma unroll
        for (unsigned j = 0; j < 16; ++j) { const unsigned c = xb_ld(&bar[XB_XCNT(j)]); sum += c; cnt += (c > 0u) ? 1u : 0u; mine = (j == x) ? c : mine; }
        if (sum == G) break;
        __builtin_amdgcn_s_sleep(1);
        if ((++sp & 255u) == 0u) { if (xb_ld(&bar[XB_TMO])) break; if (sp > XB_SPIN_CAP) { atomicAdd(&bar[XB_TMO], 1u); break; } }
    }
    nloc = mine > 0u ? mine : 1u; nx = cnt > 0u ? cnt : 1u;
}

__device__ __forceinline__ void xcd_barrier(const XcdBarrier& b) {
    asm volatile("s_waitcnt vmcnt(0)" ::: "memory");
    __syncthreads();
    int tl_ = threadIdx.x; asm volatile("" : "+v"(tl_));
    if (tl_ == 0) {
        unsigned* bar = b.bar;
        __builtin_amdgcn_s_waitcnt(0);
        unsigned nloc = b.st[0], nx = b.st[1];
        if (nloc == 0u) { xcd_barrier_complete(bar, b.x, nloc, nx); b.st[0] = nloc; b.st[1] = nx; }
        const unsigned old = xb_add(&bar[XB_XSUB(b.x)], 1u);
        const unsigned gen = old / nloc;
        if (old + 1u == (gen + 1u) * nloc) {
            __builtin_amdgcn_fence(__ATOMIC_RELEASE, "agent");
            asm volatile("s_waitcnt vmcnt(0)" ::: "memory");
            const unsigned og = xb_add(&bar[XB_TOP], 1u);
            const unsigned tg = og / nx;
            if (og + 1u == (tg + 1u) * nx) xb_add(&bar[XB_TOPGEN], 1u);
            else XB_SPIN(xb_ld(&bar[XB_TOPGEN]) == tg, bar);
            __builtin_amdgcn_fence(__ATOMIC_ACQUIRE, "agent");
            xb_add(&bar[XB_XGEN(b.x)], 1u);
            asm volatile("s_waitcnt vmcnt(0)" ::: "memory");
        } else {
            XB_SPIN(xb_ld(&bar[XB_XGEN(b.x)]) == gen, bar);
            __builtin_amdgcn_fence(__ATOMIC_ACQUIRE, "agent");
            asm volatile("s_waitcnt vmcnt(0)" ::: "memory");
        }
    }
    __syncthreads();
}

#define REP_SCAN1 1
#define REP_SCAN2 1
#define REP_P0 1
#define REP_N3 1
#define REP_G6X 0
#define REP_FOX 1
#define REP_G1 1
#define REP_XA 1
#define REP_SYNC 0
#define REP_G2 1
#ifndef PHM
#define PHM 0xffff
#endif
#ifndef DBG_STOP
#define DBG_STOP 6
#endif
struct Params { const float* in[24]; float* out; unsigned char* ws; };
__global__ void __launch_bounds__(512) mega_fwd(Params P) {
    extern __shared__ __attribute__((aligned(16))) unsigned char lds_raw[];
    LAS unsigned char* lds = (LAS unsigned char*)lds_raw;
    cg::grid_group grid = cg::this_grid();
    { volatile LAS unsigned* st0 = (volatile LAS unsigned*)(lds + 147440); if (threadIdx.x < 4) st0[threadIdx.x] = 0u; }
    __syncthreads();
    (void)xcd_barrier_post((unsigned*)(P.ws + 4096), (volatile LAS unsigned*)(lds + 147440));
#define GSYNC() do { XcdBarrier b_; b_.bar = (unsigned*)(P.ws + 4096); b_.x = xb_xcc_id(); b_.st = (volatile LAS unsigned*)(lds + 147440); xcd_barrier(b_); } while (0)
    const int tid = threadIdx.x, lane = tid & 63, wave = __builtin_amdgcn_readfirstlane(tid >> 6);
    const int G = gridDim.x, bx = blockIdx.x;
    const int gw = bx * 8 + wave, ngw = G * 8;
#define LANE_L() ({ int t_ = threadIdx.x; asm volatile("" : "+v"(t_)); t_ & 63; })
    unsigned char* ws = P.ws;
    const float* x = P.in[0];
    float* hres = P.out; bf16_t* R0 = (bf16_t*)P.out; bf16_t* R1 = R0 + (size_t)T * DM;
    float* G0 = (float*)(ws + WS_G0); float* FG = (float*)(ws + WS_FG); float* CUM = (float*)(ws + WS_CUM);
    bf16_t* MEMN = (bf16_t*)(ws + WS_MEMN); bf16_t* MEMKV = (bf16_t*)(ws + WS_MEMKV);
    bf16_t* Zb = (bf16_t*)(ws + WS_Z); bf16_t* A1 = (bf16_t*)(ws + WS_A1); bf16_t* A2 = (bf16_t*)(ws + WS_A2);
    bf16_t* WinA = (bf16_t*)(ws + W_INA); bf16_t* WinC = (bf16_t*)(ws + W_INC); bf16_t* WoutA = (bf16_t*)(ws + W_OUTA); bf16_t* WoutC = (bf16_t*)(ws + W_OUTC);
    bf16_t* Wkv = (bf16_t*)(ws + W_KV); bf16_t* W1 = (bf16_t*)(ws + W_1); bf16_t* W2 = (bf16_t*)(ws + W_2);

    float* RS = (float*)(ws + WS_RS);
    pg8::PG8F xsl = (pg8::PG8F)(lds + 131072);
#pragma unroll 1
    for (int rep_ = 0; rep_ < REP_P0; ++rep_) {
        LAS float* scr = (LAS float*)(lds + wave * 16384);
        { const int ln_ = LANE_L();
#define TJOB(W_, K_, pitch_, ncols_, gapat_, gap_, WT_, gk_) { constexpr int nblk_ = (ncols_) / 32, items_ = ((K_) / 64) * nblk_; \
            if (r_ < items_) { const int kb_ = r_ / nblk_, n0_ = 32 * (r_ % nblk_); transpose_item(W_, K_, pitch_, n0_ + (n0_ >= (gapat_) ? (gap_) : 0), WT_, n0_, scr, kb_, ln_, gk_); continue; } r_ -= items_; }
          constexpr int NITEMS_P0 = 2 * 2048 + 2 * 512 + 1024 + 4 * 512 + 2 * 2048;
#pragma unroll 1
          for (int it = gw; it < NITEMS_P0; it += ngw) { int r_ = it;
            TJOB(P.in[6], 1024, 4104, 4096, 2048, 8, WinA, nullptr)
            TJOB(P.in[13], 1024, 4104, 4096, 1 << 30, 0, WinC, P.in[2] + 1024)
            TJOB(P.in[22], 1024, 4096, 4096, 1 << 30, 0, W1, P.in[4])
            TJOB(P.in[23], 4096, 1024, 1024, 1 << 30, 0, W2, nullptr)
            TJOB(P.in[19], 1024, 2048, 2048, 1 << 30, 0, Wkv, nullptr)
            TJOB(P.in[12], 1024, 1024, 1024, 1 << 30, 0, WoutA, nullptr)
            TJOB(P.in[17], 1024, 1024, 1024, 1 << 30, 0, WoutC, nullptr)
            TJOB(P.in[20], 1024, 1024, 1024, 1 << 30, 0, (bf16_t*)(ws + W_Q0), P.in[3])
            TJOB(P.in[20] + 1024 * 1024, 1024, 1024, 1024, 1 << 30, 0, (bf16_t*)(ws + W_Q1), P.in[3] + 1024)
            TJOB(P.in[21], 1024, 1024, 1024, 1 << 30, 0, (bf16_t*)(ws + W_O0), nullptr)
            TJOB(P.in[21] + 1024 * 1024, 1024, 1024, 1024, 1 << 30, 0, (bf16_t*)(ws + W_O1), nullptr)
          }
#undef TJOB
        }
        __syncthreads();
        stage_gate_w(P.in[6], 4104, 2048, (LAS float*)lds);
        __syncthreads();
        norm_rows<false, 1>(x, P.in[2], A1, T, gw, ngw, LANE_L(), (const LAS float*)lds, P.in[8], G0);
        norm_rows<false, 0>(P.in[1], P.in[18], MEMN, 1024, gw, ngw, LANE_L(), (const LAS float*)lds, nullptr, nullptr);
        __syncthreads();
    }
    GSYNC();
    if (P.ws == nullptr) grid.sync();
#pragma unroll 1
    for (int rep_ = 0; rep_ < REP_G1; ++rep_)
    { pg8::Gemm g{A1, WinA, T, 4096, 1024}; pg8::StaticOrder S; S.init(T, 4096, G, bx);
      pg8::EpiBf16<0> E{Zb, ZW, 1.f, nullptr, (size_t)ZS}; pg8::gemm_phase<pg8::EpiBf16<0>, pg8::StaticOrder, true, true>(lds, g, S, E); }
    GSYNC();
    { const int mixer = bx >> 7, r = bx & 127, sb = r >> 5, sh = (r >> 3) & 3, sg = r & 7;
      float* LOC = (float*)(ws + WS_A1); float* VEC = (float*)(ws + WS_VEC); const float* MS = (const float*)(ws + WS_MS); const float* DCG = (const float*)(ws + WS_DCG);
      if (sg == 7) {
        pg8::Gemm g{MEMN, Wkv, 1024, 2048, 1024}; pg8::StaticOrder S; S.init(1024, 2048, 32, bx >> 3);
        pg8::EpiBf16<0> E{MEMKV, 2048, 1.f, nullptr, 0}; pg8::gemm_phase<pg8::EpiBf16<0>, pg8::StaticOrder, true, true>(lds, g, S, E); }
#pragma unroll 1
      for (int rep_ = 0; rep_ < REP_SCAN1; ++rep_)
      if (G == 256) {
        if (mixer == 0 && sg != 7) { if (wave == 0) mlstm_prescan(G0, (float*)(ws + WS_MS), (float*)(ws + WS_DCG), sb * 4 + sh, LANE_L()); __syncthreads(); }
        if (mixer == 0) scan_group<true, false>(lds, sb, sh, sg, bx, Zb, G0, P.in[7], nullptr, P.in[10], A2, LOC, VEC, MS, DCG);
        else scan_group<false, false>(lds, sb, sh, sg, bx, Zb, nullptr, nullptr, P.in[9], P.in[11], A2, LOC, VEC, MS, DCG);
      }
      GSYNC();
#pragma unroll 1
      for (int rep_ = 0; rep_ < REP_SCAN2; ++rep_)
      if (G == 256) {
        if (mixer == 0) scan_group<true, true>(lds, sb, sh, sg, bx, Zb, G0, P.in[7], nullptr, P.in[10], A2, LOC, VEC, MS, DCG);
        else scan_group<false, true>(lds, sb, sh, sg, bx, Zb, nullptr, nullptr, P.in[9], P.in[11], A2, LOC, VEC, MS, DCG);
      } }
    GSYNC();
#pragma unroll 1
    for (int rep_ = 0; rep_ < REP_G2; ++rep_)
    { pg8::Gemm g{A2, WoutA, T, 1024, 1024}; pg8::StaticOrder S; S.init(T, 1024, G, bx);
      pg8::EpiResB E{x, 1, R0, RS, xsl}; pg8::gemm_phase<pg8::EpiResB, pg8::StaticOrder, true, true>(lds, g, S, E); }
    xattn_vt_prep(MEMKV, MEMN, bx * 512 + tid);
    GSYNC();
#pragma unroll
    for (int layer = 0; layer < 2; ++layer) {
        if (layer == 1) {
            { LAS float* scr = (LAS float*)(lds + wave * 16384);
              { const int ln_ = LANE_L();
#define TJOB(W_, K_, pitch_, ncols_, WT_, gk_) { constexpr int nblk_ = (ncols_) / 32, items_ = ((K_) / 64) * nblk_; \
                if (r_ < items_) { const int kb_ = r_ / nblk_, n0_ = 32 * (r_ % nblk_); transpose_item(W_, K_, pitch_, n0_, WT_, n0_, scr, kb_, ln_, gk_); continue; } r_ -= items_; }
#pragma unroll 1
                for (int it = gw; it < 4096; it += ngw) { int r_ = it;
                  TJOB(P.in[22] + (size_t)1024 * 4096, 1024, 4096, 4096, W1, P.in[4] + 1024)
                  TJOB(P.in[23] + (size_t)1024 * 4096, 4096, 1024, 1024, W2, nullptr) }
#undef TJOB
              }
              __syncthreads();
              stage_gate_w(P.in[13], 4104, 4096, (LAS float*)lds);
              __syncthreads();
              norm_rows<false, 2, true, true>(R0, P.in[2] + 1024, nullptr, T, gw, ngw, LANE_L(), (const LAS float*)lds, P.in[14], FG); __syncthreads(); }
            { pg8::Gemm g{R0, WinC, T, 4096, 1024}; pg8::StaticOrder S; S.init(T, 4096, G, bx);
              pg8::EpiZ1 E{Zb, (size_t)ZS, P.in[15], P.in[16], xsl, A2, RS + 4 * 4 * T}; pg8::gemm_phase<pg8::EpiZ1, pg8::StaticOrder, true, true>(lds, g, S, E); }
            GSYNC();
#pragma unroll 1
            for (int rep_ = 0; rep_ < REP_FOX; ++rep_)
            for (int u = bx; u < 256; u += G) { const int bh = u >> 3, pr = u & 7;
                fox_cumsum_lds(lds, FG, bh >> 3, bh & 7);
#pragma unroll 1
                for (int hf = 0; hf < 2; ++hf) fox_unit(lds, bh >> 3, bh & 7, hf ? pr : 15 - pr, Zb, A2, A1); }
            GSYNC();
            { pg8::Gemm g{A1, WoutC, T, 1024, 1024}; pg8::StaticOrder S; S.init(T, 1024, G, bx);
              pg8::EpiResB E{R0, 0, R1, RS + 2 * 4 * T, xsl}; pg8::gemm_phase<pg8::EpiResB, pg8::StaticOrder, true, true>(lds, g, S, E); }
            GSYNC();
        }
        bf16_t* Rin = layer ? R1 : R0; bf16_t* Rmid = layer ? A2 : R1; bf16_t* Rout = R0;
        { pg8::Gemm g{Rin, (bf16_t*)(ws + (layer ? W_Q1 : W_Q0)), T, 1024, 1024}; pg8::StaticOrder S; S.init(T, 1024, G, bx);
          pg8::EpiBf16<0> E{A2, DM, 0.0625f * LOG2E, RS + (2 * layer) * 4 * T, 0}; pg8::gemm_phase<pg8::EpiBf16<0>, pg8::StaticOrder, true, true>(lds, g, S, E);
          __syncthreads();
          { pg8::StaticOrder S2; S2.init(T, 1024, G, bx); pg8::Unit un;
#pragma unroll 1
            for (int i = 0; S2.next(i, un); ++i) xattn_phase(lds, A2, MEMKV, MEMN, A1, 2 * un.pm, un.pn); } }
        GSYNC();
        { pg8::Gemm g{A1, (bf16_t*)(ws + (layer ? W_O1 : W_O0)), T, 1024, 1024}; pg8::StaticOrder S; S.init(T, 1024, G, bx);
          pg8::EpiResB E{Rin, 0, Rmid, RS + (2 * layer + 1) * 4 * T, xsl}; pg8::gemm_phase<pg8::EpiResB, pg8::StaticOrder, true, true>(lds, g, S, E); }
        GSYNC();
        { pg8::Gemm g{Rmid, W1, T, FF, 1024}; pg8::StaticOrder S; S.init(T, FF, G, bx);
          pg8::EpiBf16<2> E{Zb, FF, 1.f, RS + (2 * layer + 1) * 4 * T, 0}; pg8::gemm_phase<pg8::EpiBf16<2>, pg8::StaticOrder, true, true>(lds, g, S, E); }
        GSYNC();
#pragma unroll 1
        for (int rep_ = 0; rep_ < REP_G6X; ++rep_)
        { pg8::Gemm g{Zb, W2, T, 1024, FF}; pg8::StaticOrder S; S.init(T, 1024, G, bx);
          pg8::EpiBf16<0> E{A1, DM, 1.f, nullptr, 0}; pg8::gemm_phase<pg8::EpiBf16<0>, pg8::StaticOrder, true, true>(lds, g, S, E); }
        { pg8::Gemm g{Zb, W2, T, 1024, FF}; pg8::StaticOrder S; S.init(T, 1024, G, bx);
          if (layer == 0) { pg8::EpiResB E{Rmid, 0, Rout, RS + 4 * 4 * T, xsl}; pg8::gemm_phase<pg8::EpiResB, pg8::StaticOrder, true, true>(lds, g, S, E); }
          else { pg8::EpiResFinal E{Rmid, hres, P.in[5], RS + 4 * 4 * T, (unsigned*)(ws + 32768), xsl}; pg8::gemm_phase<pg8::EpiResFinal, pg8::StaticOrder, true, true>(lds, g, S, E); } }
        if (layer == 0) GSYNC();
    }
}

extern "C" void kernel_launch(void* const* d_in, const int* in_sizes, int n_in, void* d_out, int out_size, void* d_ws, size_t ws_size, hipStream_t stream) {
    static int grid = 0;
    if (grid == 0) {
        if (n_in != 24 || out_size != T * DM || ws_size < ((size_t)254 << 20)) { fprintf(stderr, "kernel_launch: unexpected problem (n_in %d out %d ws %zu)\n", n_in, out_size, ws_size); grid = -1; return; }
        int dev = 0, cus = 0, per_cu = 0;
        hipGetDevice(&dev); hipDeviceGetAttribute(&cus, hipDeviceAttributeMultiprocessorCount, dev);
        if (hipFuncSetAttribute((const void*)mega_fwd, hipFuncAttributeMaxDynamicSharedMemorySize, LDS_BYTES) != hipSuccess) { fprintf(stderr, "hipFuncSetAttribute failed\n"); grid = -1; return; }
        if (hipOccupancyMaxActiveBlocksPerMultiprocessor(&per_cu, (const void*)mega_fwd, 512, LDS_BYTES) != hipSuccess || per_cu < 1) { fprintf(stderr, "occupancy query: %d\n", per_cu); per_cu = 1; }
        (void)hipGetLastError();
        grid = cus * per_cu;
    }
    if (grid < 0) return;
    if (hipMemsetAsync((char*)d_ws, 0, 65536, stream) != hipSuccess) { fprintf(stderr, "memset failed\n"); return; }
    Params p{};
    for (int i = 0; i < 24; ++i) p.in[i] = (const float*)d_in[i];
    p.out = (float*)d_out; p.ws = (unsigned char*)d_ws;
    void* args[] = {&p};
    hipError_t e = hipLaunchCooperativeKernel((const void*)mega_fwd, dim3(grid), dim3(512), args, LDS_BYTES, stream);
    if (e != hipSuccess) fprintf(stderr, "cooperative launch failed: %s (grid %d)\n", hipGetErrorString(e), grid);
}
```

```cpp
#include <hip/hip_runtime.h>
#include <hip/hip_cooperative_groups.h>
#include <cstdio>
#include <cstdint>
namespace cg = cooperative_groups;
namespace pg8 {
#define PG8_LAS __attribute__((address_space(3)))
typedef unsigned short bf16_t;
typedef short bf16x8 __attribute__((ext_vector_type(8)));
typedef float f32x4 __attribute__((ext_vector_type(4)));
typedef unsigned u32x4 __attribute__((ext_vector_type(4)));
constexpr int BM = 256, BK = 64, HALF = 128, HTB = HALF * BK * 2  , STAGE_BYTES = 8 * HTB, NXCD = 8, WGM = 4;

__host__ __device__ __forceinline__ int lds_byte(int r, int c) { const int st = (r >> 4) * 2 + (c >> 5), rr = r & 15, cc = c & 31, ob = rr * 64 + cc * 2; return st * 1024 + (ob ^ (((ob >> 9) & 1) << 5)); }
__host__ __device__ __forceinline__ void stage_rc(int b, int& R, int& C) { const int st = b / 1024, sb = b % 1024, swz = sb ^ (((sb >> 9) & 1) << 5); R = (st >> 1) * 16 + swz / 64; C = (st & 1) * 32 + (swz % 64) / 2; }
__host__ __device__ __forceinline__ int perm32(int rho) { const int n = rho >> 4, i = rho & 15; return 8 * (i >> 2) + 4 * n + (i & 3); }

typedef PG8_LAS float* PG8F;
struct Unit { int pm, pn; };
struct Gemm { const bf16_t* A; const bf16_t* Bt; int M, N, K; };

struct StaticOrder {
    int nM, nN, nwg, G, c;
    __host__ __device__ __forceinline__ void init(int M, int N, int G_, int c_) { nM = M / BM; nN = N / BM; nwg = nM * nN; G = G_; c = c_; }
    __host__ __device__ __forceinline__ bool next(int i, Unit& u) const {
        const long L = (long)i * G + c; if (L >= nwg) return false;
        int wgid = (int)L; { const int q = nwg / NXCD, r = nwg % NXCD, xcd = wgid % NXCD, off = wgid / NXCD; wgid = (xcd < r ? xcd * (q + 1) : r * (q + 1) + (xcd - r) * q) + off; }
        const int nig = WGM * nN, gid = wgid / nig, fm = gid * WGM, gsz = (nM - fm) < WGM ? (nM - fm) : WGM;
        u.pm = fm + ((wgid % nig) % gsz); u.pn = (wgid % nig) / gsz; return true;
    }
    __device__ __forceinline__ void a_ready(const Unit&) const {}
    __device__ __forceinline__ void done(const Unit&) const {}
};

typedef float f32x2c __attribute__((ext_vector_type(2))); typedef __bf16 bf16x2c __attribute__((ext_vector_type(2)));
__device__ __forceinline__ unsigned cvt_pk_bf16(float lo, float hi) { const f32x2c v = {lo, hi}; return __builtin_bit_cast(unsigned, __builtin_convertvector(v, bf16x2c)); }
template <int ACT  > struct EpiBf16 {
    static constexpr bool PERM = true, AFTER_DRAIN = false;
    bf16_t* O; int ldc; float scale; const float* rs; size_t slot_stride;
    __device__ __forceinline__ void operator()(const f32x4 (&acc)[2][2][4][2], const Unit& u, int wr, int wc, int fr, int fq) const {
        const int row0 = u.pm * BM + wr * 64 + fr; const int col0 = u.pn * BM + wc * 32 + 8 * fq;
#pragma unroll
        for (int ai = 0; ai < 2; ++ai)
#pragma unroll
            for (int m = 0; m < 4; ++m) { bf16_t* rowp = slot_stride ? O + (size_t)(2 * u.pn) * slot_stride + (size_t)(row0 + ai * HALF + m * 16) * 128 + wc * 32 + 8 * fq : O + (size_t)(row0 + ai * HALF + m * 16) * ldc + col0;
                float rsc = 1.f; if (rs) { const f32x4 p4 = *(const f32x4*)(rs + (size_t)(row0 + ai * HALF + m * 16) * 4); rsc = __builtin_amdgcn_rsqf(((p4[0] + p4[1]) + (p4[2] + p4[3])) * (1.f / 1024.f) + 1e-6f); }
#pragma unroll
                for (int bj = 0; bj < 2; ++bj) { f32x4 v0 = acc[ai][bj][m][0] * rsc, v1 = acc[ai][bj][m][1] * rsc;
                    if (ACT == 2) {
#pragma unroll
                        for (int e = 0; e < 4; ++e) { float a = v0[e] > 0.f ? v0[e] : 0.f; v0[e] = a * a; float b = v1[e] > 0.f ? v1[e] : 0.f; v1[e] = b * b; } }
                    v0 = v0 * scale; v1 = v1 * scale; u32x4 w; w.x = cvt_pk_bf16(v0[0], v0[1]); w.y = cvt_pk_bf16(v0[2], v0[3]); w.z = cvt_pk_bf16(v1[0], v1[1]); w.w = cvt_pk_bf16(v1[2], v1[3]);
                    *(u32x4*)(rowp + (slot_stride ? bj * slot_stride : (size_t)(bj * HALF))) = w; } }
    }
};
struct EpiResF32 {
    static constexpr bool PERM = false, AFTER_DRAIN = false;
    const float* base; float* out; int ldc; bf16_t* hb; float* rs; PG8_LAS float* xs;
    __device__ __forceinline__ void operator()(const f32x4 (&acc)[2][2][4][2], const Unit& u, int wr, int wc, int fr, int fq) const {
        const int col0 = u.pn * BM + wc * 32 + 4 * fq;
#pragma unroll
        for (int ai = 0; ai < 2; ++ai)
#pragma unroll
            for (int m = 0; m < 4; ++m) { const size_t off = (size_t)(u.pm * BM + ai * HALF + wr * 64 + m * 16 + fr) * ldc + col0; float ssq = 0.f;
#pragma unroll
                for (int bj = 0; bj < 2; ++bj)
#pragma unroll
                    for (int n = 0; n < 2; ++n) { const f32x4 bs = *(const f32x4*)(base + off + bj * HALF + n * 16); const f32x4 v = bs + acc[ai][bj][m][n]; *(f32x4*)(out + off + bj * HALF + n * 16) = v;
                        if (hb) { ssq += (v[0] * v[0] + v[1] * v[1]) + (v[2] * v[2] + v[3] * v[3]); typedef unsigned u32x2_ __attribute__((ext_vector_type(2))); u32x2_ w; w.x = cvt_pk_bf16(v[0], v[1]); w.y = cvt_pk_bf16(v[2], v[3]); *(u32x2_*)(hb + off + bj * HALF + n * 16) = w; } }
                if (hb) { ssq += __shfl_xor(ssq, 16); ssq += __shfl_xor(ssq, 32); if (fq == 0) xs[(ai * HALF + wr * 64 + m * 16 + fr) * 4 + wc] = ssq; } }
        if (hb) {
            asm volatile("s_waitcnt lgkmcnt(0)\n\ts_barrier" ::: "memory");
            const int t_ = (wr * 4 + wc) * 64 + fq * 16 + fr;
            if (t_ < 256) { const f32x4 p4 = *(const PG8_LAS f32x4*)(xs + t_ * 4); rs[(size_t)(u.pm * BM + t_) * 4 + u.pn] = (p4[0] + p4[1]) + (p4[2] + p4[3]); } }
    }
};

struct EpiZ1 {
    static constexpr bool PERM = true, AFTER_DRAIN = false;
    bf16_t* O; size_t slot_stride; const float* gq; const float* gk; PG8_LAS float* xs; bf16_t* Vt; const float* rs;
    __device__ __forceinline__ void operator()(f32x4 (&acc)[2][2][4][2], const Unit& u, int wr, int wc, int fr, int fq) const {
        const int row0 = u.pm * BM + wr * 64 + fr; const bool qk = u.pn < 8; const bool isv = (u.pn >= 8 && u.pn < 12);
#pragma unroll
        for (int ai = 0; ai < 2; ++ai)
#pragma unroll
            for (int m = 0; m < 4; ++m) { const f32x4 p4 = *(const f32x4*)(rs + (size_t)(row0 + ai * HALF + m * 16) * 4);
                const float r_ = __builtin_amdgcn_rsqf(((p4[0] + p4[1]) + (p4[2] + p4[3])) * (1.f / 1024.f) + 1e-6f);
#pragma unroll
                for (int bj = 0; bj < 2; ++bj) { acc[ai][bj][m][0] = acc[ai][bj][m][0] * r_; acc[ai][bj][m][1] = acc[ai][bj][m][1] * r_; } }
        if (qk) {
#pragma unroll
            for (int ai = 0; ai < 2; ++ai)
#pragma unroll
                for (int m = 0; m < 4; ++m)
#pragma unroll
                    for (int bj = 0; bj < 2; ++bj) { const f32x4 v0 = acc[ai][bj][m][0], v1 = acc[ai][bj][m][1];
                        float s = ((v0[0] * v0[0] + v0[1] * v0[1]) + (v0[2] * v0[2] + v0[3] * v0[3])) + ((v1[0] * v1[0] + v1[1] * v1[1]) + (v1[2] * v1[2] + v1[3] * v1[3]));
                        s += __shfl_xor(s, 16); s += __shfl_xor(s, 32);
                        if (fq == 0) xs[((ai * HALF + wr * 64 + m * 16 + fr) * 2 + bj) * 4 + wc] = s; }
        }
        asm volatile("s_waitcnt lgkmcnt(0)\n\ts_barrier" ::: "memory");
        f32x4 gv[2][2];
        if (qk) { const float* gp = (u.pn < 4 ? gq : gk) + wc * 32 + 8 * fq; const float sc = u.pn < 4 ? 0.08838834764831845f * 1.4426950408889634f : 1.f;
#pragma unroll
            for (int bj = 0; bj < 2; ++bj) { gv[bj][0] = *(const f32x4*)gp * sc; gv[bj][1] = *(const f32x4*)(gp + 4) * sc; } }
#pragma unroll
        for (int ai = 0; ai < 2; ++ai)
#pragma unroll
            for (int m = 0; m < 4; ++m) { bf16_t* rowp = O + (size_t)(2 * u.pn) * slot_stride + (size_t)(row0 + ai * HALF + m * 16) * 128 + wc * 32 + 8 * fq;
#pragma unroll
                for (int bj = 0; bj < 2; ++bj) { f32x4 v0 = acc[ai][bj][m][0], v1 = acc[ai][bj][m][1];
                    if (qk) { const f32x4 p4 = *(const PG8_LAS f32x4*)(xs + ((ai * HALF + wr * 64 + m * 16 + fr) * 2 + bj) * 4);
                        const float r = __builtin_amdgcn_rsqf(((p4[0] + p4[1]) + (p4[2] + p4[3])) * (1.f / 128.f) + 1e-6f); v0 = v0 * r * gv[bj][0]; v1 = v1 * r * gv[bj][1]; }
                    u32x4 w; w.x = cvt_pk_bf16(v0[0], v0[1]); w.y = cvt_pk_bf16(v0[2], v0[3]); w.z = cvt_pk_bf16(v1[0], v1[1]); w.w = cvt_pk_bf16(v1[2], v1[3]);
                    if (isv) { const int row = row0 + ai * HALF + m * 16; const int bb = row >> 12, pos = row & 4095; const int hh = 2 * u.pn + bj - 16;
                        const int pk = (pos & ~63) + 32 * ((pos >> 5) & 1) + 8 * ((pos >> 2) & 3) + 4 * ((pos >> 4) & 1) + (pos & 3);
                        bf16_t* vp = Vt + ((size_t)(bb * 8 + hh) * 128 + wc * 32 + 8 * fq) * 4096 + pk; const unsigned ww[4] = {w.x, w.y, w.z, w.w};
#pragma unroll
                        for (int e = 0; e < 8; ++e) { *vp = (bf16_t)((e & 1) ? (ww[e >> 1] >> 16) : (ww[e >> 1] & 0xffffu)); vp += 4096; asm volatile("" : "+v"(vp)); } }
                    else *(u32x4*)(rowp + bj * slot_stride) = w; } }
    }
};
struct EpiResB {
    static constexpr bool PERM = true, AFTER_DRAIN = false;
    const void* base; int base_f32; bf16_t* out; float* rs; PG8_LAS float* xs;
    __device__ __forceinline__ void operator()(const f32x4 (&acc)[2][2][4][2], const Unit& u, int wr, int wc, int fr, int fq) const {
        const int row0 = u.pm * BM + wr * 64 + fr; const int col0 = u.pn * BM + wc * 32 + 8 * fq;
#pragma unroll
        for (int ai = 0; ai < 2; ++ai)
#pragma unroll
            for (int m = 0; m < 4; ++m) { const size_t off = (size_t)(row0 + ai * HALF + m * 16) * 1024 + col0; float ssq = 0.f;
#pragma unroll
                for (int bj = 0; bj < 2; ++bj) { f32x4 v0 = acc[ai][bj][m][0], v1 = acc[ai][bj][m][1];
                    if (base_f32) { const float* bp = (const float*)base + off + bj * HALF; v0 += *(const f32x4*)bp; v1 += *(const f32x4*)(bp + 4); }
                    else { const u32x4 r = *(const u32x4*)((const bf16_t*)base + off + bj * HALF);
                        v0 += (f32x4){__uint_as_float(r.x << 16), __uint_as_float(r.x & 0xffff0000u), __uint_as_float(r.y << 16), __uint_as_float(r.y & 0xffff0000u)};
                        v1 += (f32x4){__uint_as_float(r.z << 16), __uint_as_float(r.z & 0xffff0000u), __uint_as_float(r.w << 16), __uint_as_float(r.w & 0xffff0000u)}; }
                    u32x4 w; w.x = cvt_pk_bf16(v0[0], v0[1]); w.y = cvt_pk_bf16(v0[2], v0[3]); w.z = cvt_pk_bf16(v1[0], v1[1]); w.w = cvt_pk_bf16(v1[2], v1[3]);
                    *(u32x4*)(out + off + bj * HALF) = w;
                    if (rs) ssq += ((v0[0] * v0[0] + v0[1] * v0[1]) + (v0[2] * v0[2] + v0[3] * v0[3])) + ((v1[0] * v1[0] + v1[1] * v1[1]) + (v1[2] * v1[2] + v1[3] * v1[3])); }
                if (rs) { ssq += __shfl_xor(ssq, 16); ssq += __shfl_xor(ssq, 32); if (fq == 0) xs[(ai * HALF + wr * 64 + m * 16 + fr) * 4 + wc] = ssq; }
                if (base_f32 && (m & 1)) asm volatile("" ::: "memory"); }
        if (rs) {
            asm volatile("s_waitcnt lgkmcnt(0)\n\ts_barrier" ::: "memory");
            const int t_ = (wr * 4 + wc) * 64 + fq * 16 + fr;
            if (t_ < 256) { const f32x4 p4 = *(const PG8_LAS f32x4*)(xs + t_ * 4); rs[(size_t)(u.pm * BM + t_) * 4 + u.pn] = (p4[0] + p4[1]) + (p4[2] + p4[3]); } }
    }
};

struct EpiResFinal {
    static constexpr bool PERM = false, AFTER_DRAIN = false;
    const bf16_t* base; float* out; const float* gfin; float* xbuf; unsigned* cnt; PG8_LAS float* xs;
    __device__ __forceinline__ void operator()(f32x4 (&acc)[2][2][4][2], const Unit& u, int wr, int wc, int fr, int fq) const {
        const int col0 = u.pn * BM + wc * 32 + 4 * fq;
#pragma unroll
        for (int ai = 0; ai < 2; ++ai)
#pragma unroll
            for (int m = 0; m < 4; ++m) { const size_t off = (size_t)(u.pm * BM + ai * HALF + wr * 64 + m * 16 + fr) * 1024 + col0; float ssq = 0.f;
#pragma unroll
                for (int bj = 0; bj < 2; ++bj)
#pragma unroll
                    for (int n = 0; n < 2; ++n) { typedef unsigned u32x2_ __attribute__((ext_vector_type(2))); const u32x2_ r = *(const u32x2_*)(base + off + bj * HALF + n * 16);
                        f32x4 v = acc[ai][bj][m][n] + (f32x4){__uint_as_float(r.x << 16), __uint_as_float(r.x & 0xffff0000u), __uint_as_float(r.y << 16), __uint_as_float(r.y & 0xffff0000u)};
                        acc[ai][bj][m][n] = v; ssq += (v[0] * v[0] + v[1] * v[1]) + (v[2] * v[2] + v[3] * v[3]); }
                ssq += __shfl_xor(ssq, 16); ssq += __shfl_xor(ssq, 32); if (fq == 0) xs[(ai * HALF + wr * 64 + m * 16 + fr) * 4 + wc] = ssq; }
        asm volatile("s_waitcnt lgkmcnt(0)\n\ts_barrier" ::: "memory");
        const int wid = wr * 4 + wc, t_ = wid * 64 + fq * 16 + fr;
        if (t_ < 256) { const f32x4 p4 = *(const PG8_LAS f32x4*)(xs + t_ * 4);
            __hip_atomic_store(xbuf + (size_t)(u.pm * BM + t_) * 4 + u.pn, (p4[0] + p4[1]) + (p4[2] + p4[3]), __ATOMIC_RELAXED, __HIP_MEMORY_SCOPE_AGENT); }
        asm volatile("s_waitcnt vmcnt(0)" ::: "memory");
        if (wid < 4 && fq == 0 && fr == 0) __hip_atomic_fetch_add(cnt + 64 * u.pm, 1u, __ATOMIC_RELAXED, __HIP_MEMORY_SCOPE_AGENT);
        if (wid == 0) { unsigned sp = 0;
            while ((unsigned)__builtin_amdgcn_readfirstlane(__hip_atomic_load(cnt + 64 * u.pm, __ATOMIC_RELAXED, __HIP_MEMORY_SCOPE_AGENT)) < 16u) { __builtin_amdgcn_s_sleep(2); if (++sp > (1u << 22)) break; }
            __builtin_amdgcn_fence(__ATOMIC_ACQUIRE, "agent"); }
        asm volatile("s_waitcnt vmcnt(0) lgkmcnt(0)\n\ts_barrier" ::: "memory");
        f32x4 gv[2][2];
#pragma unroll
        for (int bj = 0; bj < 2; ++bj)
#pragma unroll
            for (int n = 0; n < 2; ++n) gv[bj][n] = *(const f32x4*)(gfin + col0 + bj * HALF + n * 16);
#pragma unroll
        for (int ai = 0; ai < 2; ++ai)
#pragma unroll
            for (int m = 0; m < 4; ++m) { const int row = u.pm * BM + ai * HALF + wr * 64 + m * 16 + fr; const size_t off = (size_t)row * 1024 + col0; float s = 0.f;
#pragma unroll
                for (int t = 0; t < 4; ++t) s += __hip_atomic_load(xbuf + (size_t)row * 4 + t, __ATOMIC_RELAXED, __HIP_MEMORY_SCOPE_AGENT);
                const float rstd = __builtin_amdgcn_rsqf(s * (1.f / 1024.f) + 1e-6f);
#pragma unroll
                for (int bj = 0; bj < 2; ++bj)
#pragma unroll
                    for (int n = 0; n < 2; ++n) *(f32x4*)(out + off + bj * HALF + n * 16) = acc[ai][bj][m][n] * rstd * gv[bj][n]; }
    }
};

template <class Epi, class Sched, bool ALIGN_EPI = false, bool SP2 = false>
__device__ __forceinline__ void gemm_phase(PG8_LAS unsigned char* lds, const Gemm g, const Sched& S, const Epi& E) {
    int tid = threadIdx.x; asm volatile("" : "+v"(tid)); const int wid = __builtin_amdgcn_readfirstlane(tid >> 6), lane = tid & 63, wr = wid >> 2, wc = wid & 3, fr = lane & 15, fq = lane >> 4;
    const int K = g.K, nt = K / BK;
    unsigned voffA[2], voffB[2];
#pragma unroll
    for (int i = 0; i < 2; ++i) { int R, C; stage_rc(tid * 16 + i * 8192, R, C); const int Rb = Epi::PERM ? ((R & ~31) + perm32(R & 31)) : R;
        voffA[i] = (unsigned)(R * K + C) * 2u; voffB[i] = (unsigned)(Rb * K + C) * 2u; }
    const size_t kstep = (size_t)(BK * 2);
    const size_t hstep = (size_t)HALF * K * 2;
    const size_t tstep = 2 * hstep;
    const unsigned ldsw = (unsigned)wid * 1024u;
    const int aoff = lds_byte(wr * 64 + fr, fq * 8), boff = lds_byte(wc * 32 + fr, fq * 8);
#define PG8_SA(b, h) (((b) * 2 + (h)) * HTB)
#define PG8_SB(b, h) ((4 + (b) * 2 + (h)) * HTB)
#define PG8_STAGE(bufoff, gbase, voff) do { _Pragma("unroll") for (int _i = 0; _i < 2; ++_i) \
        __builtin_amdgcn_global_load_lds((const unsigned*)((const char*)(gbase) + (voff)[_i]), (PG8_LAS unsigned*)(lds + (bufoff) + ldsw + _i * 8192), 16, 0, 0); } while (0)
#define PG8_LDA(dst, b, h) do { _Pragma("unroll") for (int m = 0; m < 4; ++m) _Pragma("unroll") for (int k = 0; k < 2; ++k) dst[m][k] = *(const PG8_LAS bf16x8*)(lds + PG8_SA(b, h) + aoff + m * 2048 + k * 1024); } while (0)
#define PG8_LDB(dst, b, h) do { _Pragma("unroll") for (int n = 0; n < 2; ++n) _Pragma("unroll") for (int k = 0; k < 2; ++k) dst[n][k] = *(const PG8_LAS bf16x8*)(lds + PG8_SB(b, h) + boff + n * 2048 + k * 1024); } while (0)
#define PG8_MMA(ai, bj, At, Bt) do { __builtin_amdgcn_s_setprio(1); _Pragma("unroll") for (int m = 0; m < 4; ++m) _Pragma("unroll") for (int n = 0; n < 2; ++n) _Pragma("unroll") for (int k = 0; k < 2; ++k) \
        acc[ai][bj][m][n] = __builtin_amdgcn_mfma_f32_16x16x32_bf16(Bt[n][k], At[m][k], acc[ai][bj][m][n], 0, 0, 0); __builtin_amdgcn_s_setprio(0); } while (0)
#define PG8_WAIT_V(n) asm volatile("s_waitcnt vmcnt(" #n ")" ::: "memory")
#define PG8_WAIT_L(n) asm volatile("s_waitcnt lgkmcnt(" #n ")" ::: "memory")
#define PG8_BAR __builtin_amdgcn_s_barrier()
#define PG8_SCHED __builtin_amdgcn_sched_barrier(0)
    Unit cur, nxt; int ui = 0;
    if (!S.next(0, cur)) return;
    f32x4 acc[2][2][4][2];
#pragma unroll
    for (int a = 0; a < 2; ++a)
#pragma unroll
        for (int b = 0; b < 2; ++b)
#pragma unroll
            for (int m = 0; m < 4; ++m)
#pragma unroll
                for (int n = 0; n < 2; ++n) acc[a][b][m][n] = (f32x4){0.f, 0.f, 0.f, 0.f};
    bf16x8 At[4][2], B0[2][2], B1[2][2];
    const char* cA = (const char*)g.A + (size_t)cur.pm * tstep; const char* cB = (const char*)g.Bt + (size_t)cur.pn * tstep;
    S.a_ready(cur);
    if constexpr (SP2) {
        PG8_STAGE(PG8_SB(0, 0), cB, voffB); PG8_STAGE(PG8_SB(0, 1), cB + hstep, voffB); PG8_STAGE(PG8_SA(0, 0), cA, voffA); PG8_STAGE(PG8_SA(0, 1), cA + hstep, voffA);
        if (wr == 1) PG8_BAR;
        PG8_WAIT_V(2); PG8_BAR;
        PG8_STAGE(PG8_SB(1, 0), cB + kstep, voffB); PG8_STAGE(PG8_SA(1, 0), cA + kstep, voffA); PG8_STAGE(PG8_SB(1, 1), cB + hstep + kstep, voffB);
        PG8_WAIT_V(6); PG8_BAR;
    } else {
        PG8_STAGE(PG8_SB(0, 0), cB, voffB); PG8_STAGE(PG8_SA(0, 0), cA, voffA); PG8_STAGE(PG8_SB(0, 1), cB + hstep, voffB); PG8_STAGE(PG8_SA(0, 1), cA + hstep, voffA);
        if (wr == 1) PG8_BAR;
        PG8_WAIT_V(4); PG8_BAR;
        PG8_STAGE(PG8_SB(1, 0), cB + kstep, voffB); PG8_STAGE(PG8_SA(1, 0), cA + kstep, voffA); PG8_STAGE(PG8_SB(1, 1), cB + hstep + kstep, voffB);
        PG8_WAIT_V(6); PG8_BAR;
    }
    for (;;) {
        const bool has_next = S.next(ui + 1, nxt);
        const char* nA = has_next ? (const char*)g.A + (size_t)nxt.pm * tstep : cA; const char* nB = has_next ? (const char*)g.Bt + (size_t)nxt.pn * tstep : cB;
        for (int t = 0; t < nt; t += 2) {
            const bool last = (t == nt - 2);
            const char* a1 = cA + (size_t)(t + 1) * kstep;
            const char* a2 = last ? nA : cA + (size_t)(t + 2) * kstep; const char* b2 = last ? nB : cB + (size_t)(t + 2) * kstep;
            const char* a3 = a2 + kstep; const char* b3 = b2 + kstep;
            if (last && has_next) S.a_ready(nxt);
            if constexpr (SP2) {
            PG8_LDB(B0, 0, 0); PG8_LDB(B1, 0, 1); PG8_SCHED; PG8_LDA(At, 0, 0); PG8_STAGE(PG8_SA(1, 1), a1 + hstep, voffA);
            PG8_WAIT_V(8); PG8_WAIT_L(0); PG8_BAR; PG8_MMA(0, 0, At, B0); PG8_MMA(0, 1, At, B1); PG8_BAR; PG8_SCHED;
            PG8_LDA(At, 0, 1); PG8_STAGE(PG8_SB(0, 0), b2, voffB); PG8_STAGE(PG8_SB(0, 1), b2 + hstep, voffB); PG8_STAGE(PG8_SA(0, 0), a2, voffA);
            PG8_WAIT_V(8); PG8_WAIT_L(0); PG8_BAR; PG8_MMA(1, 0, At, B0); PG8_MMA(1, 1, At, B1); PG8_BAR; PG8_SCHED;
            PG8_LDB(B0, 1, 0); PG8_LDB(B1, 1, 1); PG8_SCHED; PG8_LDA(At, 1, 0); PG8_STAGE(PG8_SA(0, 1), a2 + hstep, voffA);
            PG8_WAIT_V(8); PG8_WAIT_L(0); PG8_BAR; PG8_MMA(0, 0, At, B0); PG8_MMA(0, 1, At, B1); PG8_BAR; PG8_SCHED;
            PG8_LDA(At, 1, 1); PG8_STAGE(PG8_SB(1, 0), b3, voffB); PG8_STAGE(PG8_SB(1, 1), b3 + hstep, voffB); PG8_STAGE(PG8_SA(1, 0), a3, voffA);
            PG8_WAIT_V(8); PG8_WAIT_L(0); PG8_BAR; PG8_MMA(1, 0, At, B0); PG8_MMA(1, 1, At, B1); PG8_BAR; PG8_SCHED;
            } else {
            PG8_LDB(B0, 0, 0); PG8_SCHED; PG8_LDA(At, 0, 0); PG8_STAGE(PG8_SA(1, 1), a1 + hstep, voffA);
            PG8_WAIT_L(8); PG8_BAR; PG8_WAIT_L(0); PG8_MMA(0, 0, At, B0); PG8_BAR; PG8_SCHED;
            PG8_LDB(B1, 0, 1); PG8_STAGE(PG8_SB(0, 0), b2, voffB);
            PG8_BAR; PG8_WAIT_L(0); PG8_MMA(0, 1, At, B1); PG8_BAR;
            PG8_LDA(At, 0, 1); PG8_STAGE(PG8_SA(0, 0), a2, voffA);
            PG8_BAR; PG8_WAIT_L(0); PG8_MMA(1, 0, At, B0); PG8_BAR; PG8_SCHED;
            PG8_STAGE(PG8_SB(0, 1), b2 + hstep, voffB);
            PG8_WAIT_V(6); PG8_BAR; PG8_MMA(1, 1, At, B1); PG8_BAR;
            PG8_LDB(B0, 1, 0); PG8_SCHED; PG8_LDA(At, 1, 0); PG8_STAGE(PG8_SA(0, 1), a2 + hstep, voffA);
            PG8_WAIT_L(8); PG8_BAR; PG8_WAIT_L(0); PG8_MMA(0, 0, At, B0); PG8_BAR; PG8_SCHED;
            PG8_LDB(B1, 1, 1); PG8_STAGE(PG8_SB(1, 0), b3, voffB);
            PG8_BAR; PG8_WAIT_L(0); PG8_MMA(0, 1, At, B1); PG8_BAR;
            PG8_LDA(At, 1, 1); PG8_STAGE(PG8_SA(1, 0), a3, voffA);
            PG8_BAR; PG8_WAIT_L(0); PG8_MMA(1, 0, At, B0); PG8_BAR; PG8_SCHED;
            PG8_STAGE(PG8_SB(1, 1), b3 + hstep, voffB);
            PG8_WAIT_V(6); PG8_BAR; PG8_MMA(1, 1, At, B1); PG8_BAR;
            }
        }
        if constexpr (ALIGN_EPI) { if (wr == 0) PG8_BAR; }
        if constexpr (!Epi::AFTER_DRAIN) { E(acc, cur, wr, wc, fr, fq); S.done(cur); }
        if (!has_next) break;
#pragma unroll
        for (int a = 0; a < 2; ++a)
#pragma unroll
            for (int b = 0; b < 2; ++b)
#pragma unroll
                for (int m = 0; m < 4; ++m)
#pragma unroll
                    for (int n = 0; n < 2; ++n) acc[a][b][m][n] = (f32x4){0.f, 0.f, 0.f, 0.f};
        cur = nxt; cA = nA; cB = nB; ++ui;
        if constexpr (ALIGN_EPI) { if (wr == 1) PG8_BAR; }
    }
    PG8_WAIT_V(0);
    if constexpr (!ALIGN_EPI) { if (wr == 0) PG8_BAR; }
    PG8_BAR;
    if constexpr (Epi::AFTER_DRAIN) { E.fused(acc, cur, wr, wc, fr, fq, lds, wid, lane); S.done(cur); }
#undef PG8_SA
#undef PG8_SB
#undef PG8_STAGE
#undef PG8_LDA
#undef PG8_LDB
#undef PG8_MMA
#undef PG8_WAIT_V
#undef PG8_WAIT_L
#undef PG8_BAR
#undef PG8_SCHED
}
}

#define LAS __attribute__((address_space(3)))
typedef unsigned short bf16_t;
typedef float f32x4 __attribute__((ext_vector_type(4)));
typedef short bf16x8 __attribute__((ext_vector_type(8)));
typedef unsigned u32x4 __attribute__((ext_vector_type(4)));
typedef unsigned u32x2 __attribute__((ext_vector_type(2)));
typedef float f32x2_t __attribute__((ext_vector_type(2)));
constexpr int T = 16384, DM = 1024, SEQ = 4096, FF = 4096, ZW = 4160, ZS = 16384 * 128;
constexpr size_t MiB = 1u << 20;
constexpr size_t WS_G0 = 2 * MiB;
constexpr size_t WS_FG = WS_G0 + 512 * 1024;
constexpr size_t WS_CUM = WS_FG + 512 * 1024;
constexpr size_t WS_MEMN = 4 * MiB;
constexpr size_t WS_MEMKV = 6 * MiB;
constexpr size_t WS_W = 10 * MiB;
constexpr size_t W_INA = WS_W, W_INC = WS_W + 8 * MiB, W_OUTA = WS_W + 16 * MiB, W_OUTC = WS_W + 18 * MiB, W_KV = WS_W + 20 * MiB,
                 W_Q0 = WS_W + 24 * MiB, W_Q1 = WS_W + 26 * MiB, W_O0 = WS_W + 28 * MiB, W_O1 = WS_W + 30 * MiB, W_1 = WS_W + 32 * MiB, W_2 = WS_W + 40 * MiB;
constexpr size_t WS_Z = 58 * MiB, WS_A1 = 188 * MiB, WS_A2 = 220 * MiB, WS_END = 252 * MiB;
constexpr int LDS_BYTES = 147456;
constexpr float EPS = 1e-6f;
constexpr float LOG2E = 1.4426950408889634f;

__device__ __forceinline__ float bf2f(unsigned short b) { return __uint_as_float((unsigned)b << 16); }
typedef __bf16 bf16x2_hw __attribute__((ext_vector_type(2)));
__device__ __forceinline__ unsigned pk2(float lo, float hi) { const f32x2_t v = {lo, hi}; return __builtin_bit_cast(unsigned, __builtin_convertvector(v, bf16x2_hw)); }
__device__ __forceinline__ unsigned f2bf(float f) { return pk2(f, 0.f) & 0xffffu; }
__device__ __forceinline__ float wave_sum(float v) {
#pragma unroll
    for (int o = 1; o < 64; o <<= 1) v += __shfl_xor(v, o);
    return v;
}
__device__ __forceinline__ float flogf_(float x) { return __builtin_amdgcn_logf(x) * 0.6931471805599453f; }
__device__ __forceinline__ float logsigmoidf_(float x) { return fminf(x, 0.f) - flogf_(1.f + __expf(-fabsf(x))); }
__device__ __forceinline__ float rcpf_(float x) { return __builtin_amdgcn_rcpf(x); }
__device__ __forceinline__ float sigmoidf_(float x) { return rcpf_(1.f + __expf(-x)); }
__device__ __forceinline__ float siluf_(float x) { return x * rcpf_(1.f + __expf(-x)); }

#define LBAR() asm volatile("s_waitcnt lgkmcnt(0)\n\ts_barrier" ::: "memory")
#define MFMA16(a, b, c) __builtin_amdgcn_mfma_f32_16x16x32_bf16((a), (b), (c), 0, 0, 0)
__device__ __forceinline__ bf16x8 ldf(const LAS bf16_t* p) { return *(const LAS bf16x8*)p; }

__device__ __forceinline__ void transpose_item(const float* __restrict__ W, int K, int pitch, int src_col0, bf16_t* __restrict__ WT, int dst_row0, LAS float* scr, int kb, int lane, const float* __restrict__ gk) {
    const int k0 = 64 * kb;
    float r_[32], g_[32];
#pragma unroll
    for (int i = 0; i < 32; ++i) { const int kk = 2 * i + (lane >> 5); r_[i] = W[(size_t)(k0 + kk) * pitch + src_col0 + (lane & 31)]; g_[i] = gk ? gk[k0 + kk] : 1.f; }
#pragma unroll
    for (int i = 0; i < 32; ++i) { const int kk = 2 * i + (lane >> 5); scr[kk * 33 + (lane & 31)] = r_[i] * g_[i]; }
    asm volatile("s_waitcnt lgkmcnt(0)" ::: "memory");
    const int c = lane & 7;
#pragma unroll
    for (int j = 0; j < 4; ++j) { const int n = (lane >> 3) + 8 * j; const LAS float* s = scr + (8 * c) * 33 + n;
        u32x4 o; o.x = pk2(s[0 * 33], s[1 * 33]); o.y = pk2(s[2 * 33], s[3 * 33]); o.z = pk2(s[4 * 33], s[5 * 33]); o.w = pk2(s[6 * 33], s[7 * 33]);
        *(u32x4*)(WT + (size_t)(dst_row0 + n) * K + k0 + 8 * c) = o; }
    asm volatile("s_waitcnt lgkmcnt(0)" ::: "memory");
}
__device__ __forceinline__ void transpose_matrix(const float* W, int K, int pitch, int ncols, int gap_at, int gap, bf16_t* WT, LAS float* scr, int gw, int ngw, int lane, const float* gk = nullptr) {
    const int nblk = ncols / 32, items = (K / 64) * nblk;
    for (int it = gw; it < items; it += ngw) { const int kb = it / nblk, nb = it % nblk; const int n0 = 32 * nb;
        transpose_item(W, K, pitch, n0 + (n0 >= gap_at ? gap : 0), WT, n0, scr, kb, lane, gk); }
}

template <bool OUTF32, int GMODE, bool INBF16 = false, bool NOSTORE = false>
__device__ __forceinline__ void norm_rows(const void* src_, const float* __restrict__ g, void* dst, int rows, int gw, int ngw, int lane,
                                          const LAS float* Wg, const float* __restrict__ gbias, float* __restrict__ gate_out) {
    f32x4 gv[4];
#pragma unroll
    for (int j = 0; j < 4; ++j) gv[j] = *(const f32x4*)(g + 4 * lane + 256 * j);
    f32x4 nf[4]; u32x2 nb[4];
#define NR_LOAD(rr) do { _Pragma("unroll") for (int j = 0; j < 4; ++j) { if (INBF16) nb[j] = *(const u32x2*)((const bf16_t*)src_ + (size_t)(rr) * DM + 4 * lane + 256 * j); \
        else nf[j] = *(const f32x4*)((const float*)src_ + (size_t)(rr) * DM + 4 * lane + 256 * j); } } while (0)
    if (gw < rows) NR_LOAD(gw);
    for (int r = gw; r < rows; r += ngw) {
        f32x4 v[4]; float s = 0.f;
#pragma unroll
        for (int j = 0; j < 4; ++j) {
            if (INBF16) v[j] = (f32x4){__uint_as_float(nb[j].x << 16), __uint_as_float(nb[j].x & 0xffff0000u), __uint_as_float(nb[j].y << 16), __uint_as_float(nb[j].y & 0xffff0000u)};
            else v[j] = nf[j];
            s += (v[j].x * v[j].x + v[j].y * v[j].y) + (v[j].z * v[j].z + v[j].w * v[j].w); }
        if (r + ngw < rows) NR_LOAD(r + ngw);
        const float rstd = rsqrtf(wave_sum(s) * (1.f / DM) + EPS);
#pragma unroll
        for (int j = 0; j < 4; ++j) v[j] = v[j] * rstd * gv[j];
        if (NOSTORE) {} else if (OUTF32) { float* o = (float*)dst + (size_t)r * DM;
#pragma unroll
            for (int j = 0; j < 4; ++j) *(f32x4*)(o + 4 * lane + 256 * j) = v[j];
        } else { bf16_t* o = (bf16_t*)dst + (size_t)r * DM;
#pragma unroll
            for (int j = 0; j < 4; ++j) { u32x2 w; w.x = pk2(v[j].x, v[j].y); w.y = pk2(v[j].z, v[j].w); *(u32x2*)(o + 4 * lane + 256 * j) = w; } }
        if (GMODE != 0) {
            float myv = 0.f;
#pragma unroll
            for (int gi = 0; gi < 8; ++gi) { float d = 0.f;
#pragma unroll
                for (int j = 0; j < 4; ++j) { const f32x4 wv = *(const LAS f32x4*)(Wg + gi * 1024 + 4 * lane + 256 * j); d += (v[j].x * wv.x + v[j].y * wv.y) + (v[j].z * wv.z + v[j].w * wv.w); }
                d = wave_sum(d); if (lane == gi) myv = d; }
            if (lane < 8) { float val = myv + gbias[lane]; if (GMODE == 2) val = logsigmoidf_(val); gate_out[(size_t)r * 8 + lane] = val; }
        }
    }
}
#undef NR_LOAD
__device__ __forceinline__ void stage_gate_w(const float* __restrict__ W, int pitch, int col0, LAS float* Wg) {
    int t0 = threadIdx.x; asm volatile("" : "+v"(t0));
#pragma unroll 4
    for (int it = 0; it < 16; ++it) { const int idx = t0 + 512 * it; const int k = idx >> 3, gi = idx & 7; Wg[gi * 1024 + k] = W[(size_t)k * pitch + col0 + gi]; }
}

constexpr int LDQ = 136, LDP = 72, LDV = 72, LDC = 136, LDO = 132;
constexpr size_t WS_MS = 65536, WS_DCG = 65536 + 4096, WS_VEC = 1u << 20, WS_RS = (size_t)252 << 20;
__device__ __forceinline__ void mlstm_prescan(const float* __restrict__ gates, float* __restrict__ MS, float* __restrict__ DCG, int bh, int lane) {
    const int b = bh >> 2, h = bh & 3; float run = 0.f, pm = -INFINITY;
    const float* gp = gates + ((size_t)b * SEQ + 64 * lane) * 8;
    float ipv[64], fpv[64];
#pragma unroll
    for (int t = 0; t < 64; ++t) { ipv[t] = gp[t * 8 + h]; fpv[t] = gp[t * 8 + 4 + h]; }
#pragma unroll
    for (int t = 0; t < 64; ++t) { run += fminf(fpv[t], 0.f) - flogf_(1.f + __expf(-fabsf(fpv[t]))); pm = fmaxf(pm, ipv[t] - run); }
    float sa = run, sb_ = pm + run;
#pragma unroll
    for (int o = 1; o < 64; o <<= 1) { const float pa = __shfl_up(sa, o), pb = __shfl_up(sb_, o); if (lane >= o) { sb_ = fmaxf(pb + sa, sb_); sa = pa + sa; } }
    const float mnext = fmaxf(sa, sb_);
    float msv = __shfl_up(mnext, 1); if (lane == 0) msv = 0.f;
    const float dcv = __expf(msv - fmaxf(msv, pm));
    MS[bh * 64 + lane] = msv;
    float p = dcv; p *= __shfl_xor(p, 1); p *= __shfl_xor(p, 2); p *= __shfl_xor(p, 4);
    if ((lane & 7) == 0) DCG[bh * 8 + (lane >> 3)] = p;
}
template <bool MLSTM, bool FULL>
__device__ __forceinline__ void scan_group(LAS unsigned char* lds, int b, int h, int g, int unit, const bf16_t* __restrict__ Z, const float* __restrict__ gates,
                                           const float* __restrict__ convw, const float* __restrict__ lbl, const float* __restrict__ ng, bf16_t* __restrict__ Y,
                                           float* __restrict__ LOC, float* __restrict__ VEC, const float* __restrict__ MS, const float* __restrict__ DCG) {
    if (!FULL && g == 7) return;
    int tid = threadIdx.x; asm volatile("" : "+v"(tid)); const int lane = tid & 63, w = __builtin_amdgcn_readfirstlane(tid >> 6), fr = lane & 15, fq = lane >> 4;
    LAS bf16_t* Qs = (LAS bf16_t*)(lds + 0);
    LAS bf16_t* Ks = (LAS bf16_t*)(lds + 17408);
    LAS float* Os = (LAS float*)(lds + 0);
    LAS bf16_t* KhT = (LAS bf16_t*)(lds + 34816);
    LAS bf16_t* VT = (LAS bf16_t*)(lds + 53248);
    LAS bf16_t* Ps = (LAS bf16_t*)(lds + 71680);
    LAS bf16_t* CTb = (LAS bf16_t*)(lds + 80896);
    LAS float* F = (LAS float*)(lds + 115712);
    LAS float* rt = F; LAS float* av = F + 64; LAS float* winter = F + 128; LAS float* emt = F + 192; LAS float* wsv = F + 256; LAS float* den = F + 320;
    LAS float* nvec = F + 384; LAS float* bl = F + 512; LAS float* tot = F + 640; LAS float* misc = F + 1664;
    const unsigned* Zq = (const unsigned*)(Z + (size_t)(MLSTM ? h : 16 + h) * ZS) + lane;
    const unsigned* Zk = (const unsigned*)(Z + (size_t)(MLSTM ? 4 + h : 20 + h) * ZS) + lane;
    const unsigned* Zv = (const unsigned*)(Z + (size_t)(MLSTM ? 8 + h : 24 + h) * ZS) + lane;
    const bf16_t* Zg = Z + (size_t)(MLSTM ? 12 + h : 28 + h) * ZS;
    const int ybase = MLSTM ? (h * 128) : (512 + h * 128);
    float wq[2][4], wk[2][4]; float lb[2] = {0.f, 0.f};
    if (MLSTM) {
#pragma unroll
        for (int cc = 0; cc < 2; ++cc)
#pragma unroll
            for (int j = 0; j < 4; ++j) { wq[cc][j] = convw[j * 1024 + h * 128 + 2 * lane + cc]; wk[cc][j] = convw[j * 1024 + 512 + h * 128 + 2 * lane + cc]; }
    } else {
#pragma unroll
        for (int cc = 0; cc < 2; ++cc) { const float l0 = lbl[h * 128 + 2 * lane + cc], l1 = lbl[512 + h * 128 + 2 * lane + cc]; lb[cc] = 1.f / (1.f + __expf(l1 - l0)); } }
    f32x4 cacc[8];
#pragma unroll
    for (int i = 0; i < 8; ++i) cacc[i] = (f32x4){0.f, 0.f, 0.f, 0.f};
    float nv = 0.f, blsum[2] = {0.f, 0.f};
    if (FULL) {
        f32x4 bufA[8], bufB[8], vecA[8], vecB[8]; float nA = 0.f, nB = 0.f;
#define SG_LOAD(gp_, buf, vec, nn) do { const int up_ = unit - g + (gp_); const float* lp_ = LOC + (size_t)up_ * 16384; \
            _Pragma("unroll") for (int dt = 0; dt < 8; ++dt) { buf[dt] = *(const f32x4*)(lp_ + (size_t)(dt * 512 + tid) * 4); if (!MLSTM) vec[dt] = *(const f32x4*)(VEC + (size_t)up_ * 128 + 16 * dt + 4 * fq); } \
            if (MLSTM) nn = VEC[(size_t)up_ * 128 + (tid & 127)]; } while (0)
#define SG_COMB(gp_, buf, vec, nn) do { float dsc = 1.f; if (MLSTM) dsc = DCG[(b * 4 + h) * 8 + (gp_)]; \
            _Pragma("unroll") for (int dt = 0; dt < 8; ++dt) { f32x4 sc; if (MLSTM) sc = (f32x4){dsc, dsc, dsc, dsc}; else sc = (f32x4){__expf(vec[dt][0]), __expf(vec[dt][1]), __expf(vec[dt][2]), __expf(vec[dt][3])}; \
                cacc[dt] = cacc[dt] * sc + buf[dt]; } \
            if (MLSTM) nv = dsc * nv + nn; } while (0)
        if (g > 0) SG_LOAD(0, bufA, vecA, nA);
#pragma unroll 1
        for (int gp = 0; gp < g; gp += 2) {
            if (gp + 1 < g) SG_LOAD(gp + 1, bufB, vecB, nB);
            SG_COMB(gp, bufA, vecA, nA);
            if (gp + 1 < g) { if (gp + 2 < g) SG_LOAD(gp + 2, bufA, vecA, nA); SG_COMB(gp + 1, bufB, vecB, nB); }
        }
#undef SG_LOAD
#undef SG_COMB
#pragma unroll
        for (int dt = 0; dt < 8; ++dt) { u32x2 pkd; pkd.x = pk2(cacc[dt][0], cacc[dt][1]); pkd.y = pk2(cacc[dt][2], cacc[dt][3]);
            *(LAS u32x2*)(CTb + (16 * w + fr) * LDC + 16 * dt + 4 * fq) = pkd; }
    }
    if (tid < 128) nvec[tid] = nv;
    float m_carry = MLSTM ? MS[(b * 4 + h) * 64 + 8 * g] : 0.f;
    unsigned rk[11], rq[11], rq8[8], rv[8]; u32x4 gE0 = (u32x4){0u, 0u, 0u, 0u}, gE1 = gE0; float gi = 0.f, gf = 0.f;
#define SCAN_LOAD(cc) do { const long rb_ = (long)b * SEQ + (cc) * 64; \
        if (MLSTM) { _Pragma("unroll") for (int i = 0; i < 11; ++i) { const int r = 8 * w - 3 + i; const int pos = (cc) * 64 + r; \
                rk[i] = Zk[(rb_ + (pos >= 0 ? r : 0)) * 64]; if (FULL) rq[i] = Zq[(rb_ + (pos >= 0 ? r : 0)) * 64]; } \
            _Pragma("unroll") for (int i = 0; i < 8; ++i) rv[i] = Zv[(rb_ + 8 * w + i) * 64]; \
            if (w == 0) { gi = gates[(rb_ + lane) * 8 + h]; gf = gates[(rb_ + lane) * 8 + 4 + h]; } \
        } else { _Pragma("unroll") for (int i = 0; i < 8; ++i) { rk[i] = Zk[(rb_ + 8 * w + i) * 64]; if (FULL) rq8[i] = Zq[(rb_ + 8 * w + i) * 64]; rv[i] = Zv[(rb_ + 8 * w + i) * 64]; } } \
        } while (0)
    SCAN_LOAD(8 * g);
    __syncthreads();
#pragma unroll 1
    for (int c = 8 * g; c < 8 * g + 8; ++c) {
        const long rowbase = (long)b * SEQ + c * 64;
        float kreg[2][8];
        if (MLSTM) {
            if (c == 0 && w == 0) { rk[0] = 0u; rk[1] = 0u; rk[2] = 0u; if (FULL) { rq[0] = 0u; rq[1] = 0u; rq[2] = 0u; } }
#pragma unroll
            for (int i = 0; i < 8; ++i) { const int row = 8 * w + i;
                const float y0 = wk[0][0] * bf2f(rk[i] & 0xffffu) + wk[0][1] * bf2f(rk[i + 1] & 0xffffu) + wk[0][2] * bf2f(rk[i + 2] & 0xffffu) + wk[0][3] * bf2f(rk[i + 3] & 0xffffu);
                const float y1 = wk[1][0] * bf2f(rk[i] >> 16) + wk[1][1] * bf2f(rk[i + 1] >> 16) + wk[1][2] * bf2f(rk[i + 2] >> 16) + wk[1][3] * bf2f(rk[i + 3] >> 16);
                kreg[0][i] = siluf_(y0) * 0.08838834764831845f; kreg[1][i] = siluf_(y1) * 0.08838834764831845f;
                if (FULL) *(LAS unsigned*)(Ks + row * LDQ + 2 * lane) = pk2(kreg[0][i], kreg[1][i]); }
            { u32x4 lo, hi;
              lo.x = (rv[0] & 0xffffu) | (rv[1] << 16); lo.y = (rv[2] & 0xffffu) | (rv[3] << 16); lo.z = (rv[4] & 0xffffu) | (rv[5] << 16); lo.w = (rv[6] & 0xffffu) | (rv[7] << 16);
              hi.x = (rv[0] >> 16) | (rv[1] & 0xffff0000u); hi.y = (rv[2] >> 16) | (rv[3] & 0xffff0000u); hi.z = (rv[4] >> 16) | (rv[5] & 0xffff0000u); hi.w = (rv[6] >> 16) | (rv[7] & 0xffff0000u);
              *(LAS u32x4*)(VT + (2 * lane) * LDV + 8 * w) = lo; *(LAS u32x4*)(VT + (2 * lane + 1) * LDV + 8 * w) = hi; }
            if (FULL) {
#pragma unroll
                for (int i = 0; i < 8; ++i) {
                    const float y0 = wq[0][0] * bf2f(rq[i] & 0xffffu) + wq[0][1] * bf2f(rq[i + 1] & 0xffffu) + wq[0][2] * bf2f(rq[i + 2] & 0xffffu) + wq[0][3] * bf2f(rq[i + 3] & 0xffffu);
                    const float y1 = wq[1][0] * bf2f(rq[i] >> 16) + wq[1][1] * bf2f(rq[i + 1] >> 16) + wq[1][2] * bf2f(rq[i + 2] >> 16) + wq[1][3] * bf2f(rq[i + 3] >> 16);
                    *(LAS unsigned*)(Qs + (8 * w + i) * LDQ + 2 * lane) = pk2(siluf_(y0), siluf_(y1)); } }
            if (w == 0) {
                float bc = fminf(gf, 0.f) - flogf_(1.f + __expf(-fabsf(gf)));
#pragma unroll
                for (int o = 1; o < 64; o <<= 1) { const float t_ = __shfl_up(bc, o); if (lane >= o) bc += t_; }
                const float a_ = gi - bc; float pm = a_;
#pragma unroll
                for (int o = 1; o < 64; o <<= 1) { const float t_ = __shfl_up(pm, o); if (lane >= o) pm = fmaxf(pm, t_); }
                const float mx = fmaxf(m_carry, pm);
                rt[lane] = -mx; av[lane] = a_; winter[lane] = __expf(m_carry - mx); emt[lane] = __expf(-(bc + mx));
                const float pm63 = __shfl(pm, 63), bl63 = __shfl(bc, 63);
                const float mx63 = fmaxf(m_carry, pm63);
                wsv[lane] = __expf(a_ - mx63);
                if (lane == 0) misc[0] = __expf(m_carry - mx63);
                m_carry = bl63 + mx63;
            }
        } else {
            float lc[2][8], qs[2][8], vs[2][8]; float run[2] = {0.f, 0.f};
#pragma unroll
            for (int i = 0; i < 8; ++i)
#pragma unroll
                for (int cc = 0; cc < 2; ++cc) {
                    const float zf = bf2f(cc ? (rk[i] >> 16) : (rk[i] & 0xffffu));
                    const float sg = rcpf_(1.f + __expf(-zf)), sgn = rcpf_(1.f + __expf(zf));
                    const float f = lb[cc] + (1.f - lb[cc]) * sg; run[cc] += flogf_(f); lc[cc][i] = run[cc]; kreg[cc][i] = (1.f - lb[cc]) * sgn;
                    if (FULL) qs[cc][i] = siluf_(bf2f(cc ? (rq8[i] >> 16) : (rq8[i] & 0xffffu)));
                    vs[cc][i] = siluf_(bf2f(cc ? (rv[i] >> 16) : (rv[i] & 0xffffu))); }
#pragma unroll
            for (int cc = 0; cc < 2; ++cc) { u32x4 vv; vv.x = pk2(vs[cc][0], vs[cc][1]); vv.y = pk2(vs[cc][2], vs[cc][3]); vv.z = pk2(vs[cc][4], vs[cc][5]); vv.w = pk2(vs[cc][6], vs[cc][7]);
                *(LAS u32x4*)(VT + (2 * lane + cc) * LDV + 8 * w) = vv; }
            *(LAS f32x2_t*)(tot + w * 128 + 2 * lane) = (f32x2_t){run[0], run[1]};
            LBAR();
            float prefix[2] = {0.f, 0.f}, total[2] = {0.f, 0.f};
#pragma unroll
            for (int p_ = 0; p_ < 8; ++p_) { const f32x2_t tv = *(const LAS f32x2_t*)(tot + p_ * 128 + 2 * lane); total[0] += tv.x; total[1] += tv.y; if (p_ < w) { prefix[0] += tv.x; prefix[1] += tv.y; } }
            blsum[0] += total[0]; blsum[1] += total[1];
            float kh[2][8];
#pragma unroll
            for (int i = 0; i < 8; ++i) { const int row = 8 * w + i; const float b0 = prefix[0] + lc[0][i], b1 = prefix[1] + lc[1][i];
                if (FULL) { *(LAS unsigned*)(Qs + row * LDQ + 2 * lane) = pk2(qs[0][i] * __expf(b0), qs[1][i] * __expf(b1));
                            *(LAS unsigned*)(Ks + row * LDQ + 2 * lane) = pk2(kreg[0][i] * __expf(-b0), kreg[1][i] * __expf(-b1)); }
                kh[0][i] = kreg[0][i] * __expf(total[0] - b0); kh[1][i] = kreg[1][i] * __expf(total[1] - b1); }
#pragma unroll
            for (int cc = 0; cc < 2; ++cc) { u32x4 kk4; kk4.x = pk2(kh[cc][0], kh[cc][1]); kk4.y = pk2(kh[cc][2], kh[cc][3]); kk4.z = pk2(kh[cc][4], kh[cc][5]); kk4.w = pk2(kh[cc][6], kh[cc][7]);
                *(LAS u32x4*)(KhT + (2 * lane + cc) * LDV + 8 * w) = kk4; }
            if (w == 0) *(LAS f32x2_t*)(bl + 2 * lane) = (f32x2_t){__expf(total[0]), __expf(total[1])};
        }
        if (c + 1 < 8 * g + 8) SCAN_LOAD(c + 1);
        LBAR();
        if (FULL) { const bf16_t* gp_ = Zg + (rowbase + (tid >> 3)) * 128 + 16 * (tid & 7); gE0 = *(const u32x4*)gp_; gE1 = *(const u32x4*)(gp_ + 8); }
        if (MLSTM) { const f32x4 w0 = *(const LAS f32x4*)(wsv + 8 * w), w1 = *(const LAS f32x4*)(wsv + 8 * w + 4);
#pragma unroll
            for (int cc = 0; cc < 2; ++cc) { u32x4 kk4; kk4.x = pk2(kreg[cc][0] * w0[0], kreg[cc][1] * w0[1]); kk4.y = pk2(kreg[cc][2] * w0[2], kreg[cc][3] * w0[3]);
                kk4.z = pk2(kreg[cc][4] * w1[0], kreg[cc][5] * w1[1]); kk4.w = pk2(kreg[cc][6] * w1[2], kreg[cc][7] * w1[3]);
                *(LAS u32x4*)(KhT + (2 * lane + cc) * LDV + 8 * w) = kk4; } }
        if (FULL) { const int tt = w >> 1, st0 = 2 * (w & 1);
            f32x4 s_[2] = {(f32x4){0.f, 0.f, 0.f, 0.f}, (f32x4){0.f, 0.f, 0.f, 0.f}};
#pragma unroll
            for (int kk = 0; kk < 4; ++kk) { const bf16x8 a = ldf(Qs + (16 * tt + fr) * LDQ + 32 * kk + 8 * fq);
#pragma unroll
                for (int i = 0; i < 2; ++i) { const bf16x8 bb = ldf(Ks + (16 * (st0 + i) + fr) * LDQ + 32 * kk + 8 * fq); s_[i] = MFMA16(a, bb, s_[i]); } }
#pragma unroll
            for (int i = 0; i < 2; ++i) { const int si = 16 * (st0 + i) + fr;
#pragma unroll
                for (int j = 0; j < 4; ++j) { const int t_ = 16 * tt + 4 * fq + j; float pv = 0.f;
                    if (si <= t_) pv = MLSTM ? s_[i][j] * __expf(rt[t_] + av[si]) : s_[i][j];
                    Ps[t_ * LDP + si] = (bf16_t)f2bf(pv); } } }
        if (FULL || MLSTM) LBAR();
        if (FULL && MLSTM) { const int t_ = tid >> 3, sub = tid & 7; float s8 = 0.f, qn = 0.f;
#pragma unroll
            for (int i = 0; i < 8; ++i) s8 += bf2f(Ps[t_ * LDP + 8 * sub + i]);
#pragma unroll
            for (int i = 0; i < 16; ++i) qn += bf2f(Qs[t_ * LDQ + 16 * sub + i]) * nvec[16 * sub + i];
            float val = s8 + winter[t_] * qn; val += __shfl_xor(val, 1); val += __shfl_xor(val, 2); val += __shfl_xor(val, 4);
            if (sub == 0) den[t_] = val; }
        f32x4 oacc[4];
        { bf16x8 vb[2]; vb[0] = ldf(VT + (16 * w + fr) * LDV + 8 * fq); vb[1] = ldf(VT + (16 * w + fr) * LDV + 32 + 8 * fq);
            if (FULL) { bf16x8 cb[4];
#pragma unroll
                for (int kk = 0; kk < 4; ++kk) cb[kk] = ldf(CTb + (16 * w + fr) * LDC + 32 * kk + 8 * fq);
#pragma unroll
                for (int tt = 0; tt < 4; ++tt) { f32x4 a1 = (f32x4){0.f, 0.f, 0.f, 0.f}, a2 = (f32x4){0.f, 0.f, 0.f, 0.f};
#pragma unroll
                    for (int kk = 0; kk < 2; ++kk) a1 = MFMA16(ldf(Ps + (16 * tt + fr) * LDP + 32 * kk + 8 * fq), vb[kk], a1);
#pragma unroll
                    for (int kk = 0; kk < 4; ++kk) a2 = MFMA16(ldf(Qs + (16 * tt + fr) * LDQ + 32 * kk + 8 * fq), cb[kk], a2);
                    if (MLSTM) { const f32x4 wi = *(const LAS f32x4*)(winter + 16 * tt + 4 * fq); oacc[tt] = a1 + wi * a2; } else oacc[tt] = a1 + a2;
                    __builtin_amdgcn_sched_barrier(0); } }
            const float dec = MLSTM ? misc[0] : 0.f;
            { bf16x8 kfr[2][2];
#pragma unroll
              for (int kk = 0; kk < 2; ++kk) kfr[0][kk] = ldf(KhT + fr * LDV + 32 * kk + 8 * fq);
#pragma unroll
              for (int dt = 0; dt < 8; ++dt) {
                if (dt < 7) {
#pragma unroll
                    for (int kk = 0; kk < 2; ++kk) kfr[(dt + 1) & 1][kk] = ldf(KhT + (16 * (dt + 1) + fr) * LDV + 32 * kk + 8 * fq); }
                f32x4 sc; if (MLSTM) sc = (f32x4){dec, dec, dec, dec}; else sc = *(const LAS f32x4*)(bl + 16 * dt + 4 * fq);
                __builtin_amdgcn_sched_barrier(0);
                f32x4 a = cacc[dt] * sc;
#pragma unroll
                for (int kk = 0; kk < 2; ++kk) a = MFMA16(kfr[dt & 1][kk], vb[kk], a);
                cacc[dt] = a; __builtin_amdgcn_sched_barrier(0); } } }
        if (FULL) LBAR();
        if (FULL) {
#pragma unroll
            for (int tt = 0; tt < 4; ++tt)
#pragma unroll
                for (int j = 0; j < 4; ++j) Os[(16 * tt + 4 * fq + j) * LDO + 16 * w + fr] = oacc[tt][j];
#pragma unroll
            for (int dt = 0; dt < 8; ++dt) { u32x2 pkd; pkd.x = pk2(cacc[dt][0], cacc[dt][1]); pkd.y = pk2(cacc[dt][2], cacc[dt][3]);
                *(LAS u32x2*)(CTb + (16 * w + fr) * LDC + 16 * dt + 4 * fq) = pkd; } }
        if (MLSTM && tid < 128) { float sm = 0.f;
#pragma unroll
            for (int i = 0; i < 8; ++i) { const u32x4 kk4 = *(const LAS u32x4*)(KhT + tid * LDV + 8 * i);
                sm += (bf2f((unsigned short)(kk4.x & 0xffffu)) + bf2f((unsigned short)(kk4.x >> 16))) + (bf2f((unsigned short)(kk4.y & 0xffffu)) + bf2f((unsigned short)(kk4.y >> 16)))
                    + (bf2f((unsigned short)(kk4.z & 0xffffu)) + bf2f((unsigned short)(kk4.z >> 16))) + (bf2f((unsigned short)(kk4.w & 0xffffu)) + bf2f((unsigned short)(kk4.w >> 16))); }
            nvec[tid] = misc[0] * nvec[tid] + sm; }
        LBAR();
        if (FULL) { const int t_ = tid >> 3, sub = tid & 7;
            const unsigned gw_[8] = {gE0.x, gE0.y, gE0.z, gE0.w, gE1.x, gE1.y, gE1.z, gE1.w};
            float o[16]; float inv = 1.f;
            if (MLSTM) inv = rcpf_(fmaxf(fabsf(den[t_]), emt[t_]));
            float ss = 0.f;
#pragma unroll
            for (int i = 0; i < 16; ++i) { const float gv_ = bf2f((unsigned short)((i & 1) ? (gw_[i >> 1] >> 16) : (gw_[i >> 1] & 0xffffu)));
                float x = Os[t_ * LDO + 16 * sub + i];
                if (MLSTM) x = x * inv * sigmoidf_(gv_);
                o[i] = x; ss += x * x;
                if (!MLSTM) o[i] = x * siluf_(gv_); }
            ss += __shfl_xor(ss, 1); ss += __shfl_xor(ss, 2); ss += __shfl_xor(ss, 4);
            const float rstd = rsqrtf(ss * (1.f / 128.f) + EPS);
            unsigned op[8];
#pragma unroll
            for (int i = 0; i < 8; ++i) op[i] = pk2(o[2 * i] * rstd * ng[h * 128 + 16 * sub + 2 * i], o[2 * i + 1] * rstd * ng[h * 128 + 16 * sub + 2 * i + 1]);
            bf16_t* yp = Y + (rowbase + t_) * DM + ybase + 16 * sub;
            *(u32x4*)yp = (u32x4){op[0], op[1], op[2], op[3]}; *(u32x4*)(yp + 8) = (u32x4){op[4], op[5], op[6], op[7]};
            LBAR();
        }
    }
#undef SCAN_LOAD
    if (!FULL) {
        float* lp = LOC + (size_t)unit * 16384;
#pragma unroll
        for (int dt = 0; dt < 8; ++dt) *(f32x4*)(lp + (size_t)(dt * 512 + tid) * 4) = cacc[dt];
        if (MLSTM) { if (tid < 128) VEC[(size_t)unit * 128 + tid] = nvec[tid]; }
        else if (w == 0) { VEC[(size_t)unit * 128 + 2 * lane] = blsum[0]; VEC[(size_t)unit * 128 + 2 * lane + 1] = blsum[1]; }
    }
}

__device__ __forceinline__ int pcol(int key) { return 32 * (key >> 5) + 8 * ((key >> 2) & 3) + 4 * ((key >> 4) & 1) + (key & 3); }
__device__ __forceinline__ float ex2(float x) { return __builtin_amdgcn_exp2f(x); }

__device__ __forceinline__ int pcol256(int key) { return (key & ~63) | pcol(key & 63); }
__device__ __forceinline__ void xattn_vt_prep(const bf16_t* __restrict__ KV, bf16_t* __restrict__ Vt, int gid) {
    const int e8 = gid & 31, hx = (gid >> 5) & 3, key = (gid >> 7) & 255, b = gid >> 15;
    const u32x4 vv = *(const u32x4*)(KV + (size_t)(b * 256 + key) * 2048 + 1024 + hx * 256 + 8 * e8); const unsigned vw[4] = {vv.x, vv.y, vv.z, vv.w};
    bf16_t* dst = Vt + ((size_t)(b * 4 + hx) * 256 + 8 * e8) * 256 + pcol256(key);
#pragma unroll
    for (int e = 0; e < 8; ++e) dst[e * 256] = (bf16_t)((e & 1) ? (vw[e >> 1] >> 16) : (vw[e >> 1] & 0xffffu));
}
__device__ __forceinline__ void xattn_phase(LAS unsigned char* lds, const bf16_t* __restrict__ Q, const bf16_t* __restrict__ KV, const bf16_t* __restrict__ Vt, bf16_t* __restrict__ O, int rb0, int hx) {
    constexpr int KBUF = 32768, XBUF = 65536;
    int tid = threadIdx.x; asm volatile("" : "+v"(tid)); const int lane = tid & 63, w = __builtin_amdgcn_readfirstlane(tid >> 6), fr = lane & 15, fq = lane >> 4;
    const int ka0 = (fr >> 1) * 1024 + (fr & 1) * 512 + ((fq ^ (fr & 3)) << 4), kx = fr >> 2;
    const int va0 = KBUF + fr * 128;
#pragma unroll 1
    for (int rb = rb0; rb < rb0 + 2; ++rb) {
        const int row0 = rb * 128 + 16 * w; const int b = (rb * 128) / SEQ;
#define XA_DMA(kt_, buf_) do { \
            _Pragma("unroll") for (int i = 0; i < 4; ++i) { const int j = 4 * w + i; const int row = 2 * j + (lane >> 5); const int c = (lane & 31) ^ (row & 15); \
                __builtin_amdgcn_global_load_lds((const unsigned*)(KV + (size_t)(b * 256 + 64 * (kt_) + row) * 2048 + hx * 256 + 8 * c), (LAS unsigned*)(lds + (buf_) * XBUF + j * 1024), 16, 0, 0); } \
            _Pragma("unroll") for (int i = 0; i < 4; ++i) { const int j = 4 * w + i; const int row = 8 * j + (lane >> 3); const int c = (lane & 7) ^ ((row >> 1) & 7); \
                __builtin_amdgcn_global_load_lds((const unsigned*)(Vt + ((size_t)(b * 4 + hx) * 256 + row) * 256 + 64 * (kt_) + 8 * c), (LAS unsigned*)(lds + (buf_) * XBUF + KBUF + j * 1024), 16, 0, 0); } } while (0)
        XA_DMA(0, 0);
        bf16x8 qf[8];
#pragma unroll
        for (int kk = 0; kk < 8; ++kk) qf[kk] = *(const bf16x8*)(Q + (size_t)(row0 + fr) * DM + hx * 256 + 32 * kk + 8 * fq);
        f32x4 ot[16];
#pragma unroll
        for (int i = 0; i < 16; ++i) ot[i] = (f32x4){0.f, 0.f, 0.f, 0.f};
        float mrun = -INFINITY, lrun = 0.f;
        asm volatile("s_waitcnt vmcnt(0)" ::: "memory");
        LBAR();
        for (int kt = 0; kt < 4; ++kt) {
            if (kt + 1 < 4) XA_DMA(kt + 1, (kt + 1) & 1);
            const LAS unsigned char* Kb = lds + (kt & 1) * XBUF;
            f32x4 st[4];
            { bf16x8 kfr[2][4];
#pragma unroll
              for (int kk = 0; kk < 4; ++kk) kfr[0][kk] = *(const LAS bf16x8*)(Kb + ka0 + ((kk ^ kx) << 6));
#pragma unroll
              for (int hb = 0; hb < 8; ++hb) { const int k16 = hb >> 1, k0 = 4 * (hb & 1);
                if (hb < 7) { const int n16 = (hb + 1) >> 1, n0 = 4 * ((hb + 1) & 1);
#pragma unroll
                    for (int kk = 0; kk < 4; ++kk) kfr[(hb + 1) & 1][kk] = *(const LAS bf16x8*)(Kb + n16 * 8192 + ka0 + (((n0 + kk) ^ kx) << 6)); }
                __builtin_amdgcn_sched_barrier(0);
                f32x4 a = (hb & 1) ? st[k16] : (f32x4){0.f, 0.f, 0.f, 0.f};
#pragma unroll
                for (int kk = 0; kk < 4; ++kk) a = MFMA16(kfr[hb & 1][kk], qf[k0 + kk], a);
                st[k16] = a; __builtin_amdgcn_sched_barrier(0); } }
            float mx = -INFINITY;
#pragma unroll
            for (int k16 = 0; k16 < 4; ++k16)
#pragma unroll
                for (int j = 0; j < 4; ++j) mx = fmaxf(mx, st[k16][j]);
            mx = fmaxf(mx, __shfl_xor(mx, 16)); mx = fmaxf(mx, __shfl_xor(mx, 32));
            const float mnew = fmaxf(mrun, mx), alpha = ex2(mrun - mnew); mrun = mnew;
            float ps = 0.f;
#pragma unroll
            for (int k16 = 0; k16 < 4; ++k16)
#pragma unroll
                for (int j = 0; j < 4; ++j) { const float p = ex2(st[k16][j] - mnew); st[k16][j] = p; ps += p; }
            lrun = lrun * alpha + ps;
            bf16x8 pf[2];
#pragma unroll
            for (int kb = 0; kb < 2; ++kb) { u32x4 pw; pw.x = pk2(st[2 * kb][0], st[2 * kb][1]); pw.y = pk2(st[2 * kb][2], st[2 * kb][3]); pw.z = pk2(st[2 * kb + 1][0], st[2 * kb + 1][1]); pw.w = pk2(st[2 * kb + 1][2], st[2 * kb + 1][3]);
                pf[kb] = __builtin_bit_cast(bf16x8, pw); }
            { bf16x8 vfr[2][2];
#pragma unroll
              for (int kb = 0; kb < 2; ++kb) vfr[0][kb] = *(const LAS bf16x8*)(Kb + va0 + (((4 * kb + fq) ^ (fr >> 1)) << 4));
#pragma unroll
              for (int et = 0; et < 16; ++et) {
                if (et < 15) {
#pragma unroll
                    for (int kb = 0; kb < 2; ++kb) vfr[(et + 1) & 1][kb] = *(const LAS bf16x8*)(Kb + (et + 1) * 2048 + va0 + (((4 * kb + fq) ^ (fr >> 1)) << 4)); }
                __builtin_amdgcn_sched_barrier(0);
                f32x4 a = ot[et] * alpha;
#pragma unroll
                for (int kb = 0; kb < 2; ++kb) a = MFMA16(vfr[et & 1][kb], pf[kb], a);
                ot[et] = a; __builtin_amdgcn_sched_barrier(0); } }
            asm volatile("s_waitcnt vmcnt(0)" ::: "memory");
            LBAR();
        }
#undef XA_DMA
        lrun += __shfl_xor(lrun, 16); lrun += __shfl_xor(lrun, 32);
        const float inv = 1.f / lrun;
        bf16_t* op = O + (size_t)(row0 + fr) * DM + hx * 256 + 4 * fq;
#pragma unroll
        for (int et = 0; et < 16; ++et) { u32x2 wv; wv.x = pk2(ot[et][0] * inv, ot[et][1] * inv); wv.y = pk2(ot[et][2] * inv, ot[et][3] * inv); *(u32x2*)(op + 16 * et) = wv; }
    }
}

__device__ __forceinline__ void fox_prep(bf16_t* Z, const float* __restrict__ gq, const float* __restrict__ gk, int gw, int ngw, int lane) {
    const int e0 = 8 * (lane & 15);
    for (int task = gw; task < 16 * (T / 4); task += ngw) { const int slot = task / (T / 4), row = 4 * (task % (T / 4)) + (lane >> 4);
        bf16_t* p = Z + (size_t)slot * ZS + (size_t)row * 128 + e0;
        const u32x4 raw = *(const u32x4*)p; const unsigned rw[4] = {raw.x, raw.y, raw.z, raw.w};
        float x[8]; float ss = 0.f;
#pragma unroll
        for (int i = 0; i < 8; ++i) { x[i] = bf2f((unsigned short)((i & 1) ? (rw[i >> 1] >> 16) : (rw[i >> 1] & 0xffffu))); ss += x[i] * x[i]; }
        ss += __shfl_xor(ss, 1); ss += __shfl_xor(ss, 2); ss += __shfl_xor(ss, 4); ss += __shfl_xor(ss, 8);
        float sc = rsqrtf(ss * (1.f / 128.f) + EPS); const float* g = (slot < 8) ? gq : gk; if (slot < 8) sc *= 0.08838834764831845f * LOG2E;
        u32x4 o; o.x = pk2(x[0] * sc * g[e0], x[1] * sc * g[e0 + 1]); o.y = pk2(x[2] * sc * g[e0 + 2], x[3] * sc * g[e0 + 3]);
        o.z = pk2(x[4] * sc * g[e0 + 4], x[5] * sc * g[e0 + 5]); o.w = pk2(x[6] * sc * g[e0 + 6], x[7] * sc * g[e0 + 7]);
        *(u32x4*)p = o; }
}
__device__ __forceinline__ void fox_cumsum(const float* __restrict__ FG, float* __restrict__ CUM, int bh, int lane) {
    const int b = bh >> 3, h = bh & 7; float v[64]; float run = 0.f;
    const float* p = FG + ((size_t)b * SEQ + 64 * lane) * 8 + h;
#pragma unroll
    for (int i = 0; i < 64; ++i) v[i] = p[i * 8];
#pragma unroll
    for (int i = 0; i < 64; ++i) { run += v[i]; v[i] = run; }
    float inc = run;
#pragma unroll
    for (int o = 1; o < 64; o <<= 1) { const float t_ = __shfl_up(inc, o); if (lane >= o) inc += t_; }
    const float base = inc - run; float* q = CUM + (size_t)bh * SEQ + 64 * lane;
#pragma unroll
    for (int i = 0; i < 16; ++i) *(f32x4*)(q + 4 * i) = (f32x4){base + v[4 * i], base + v[4 * i + 1], base + v[4 * i + 2], base + v[4 * i + 3]};
}

__device__ __forceinline__ void fox_cumsum_lds(LAS unsigned char* lds, const float* __restrict__ FG, int b, int h) {
    int tid = threadIdx.x; asm volatile("" : "+v"(tid)); const int lane = tid & 63, w = __builtin_amdgcn_readfirstlane(tid >> 6);
    LAS float* cumL = (LAS float*)(lds + 66560); LAS float* wtot = (LAS float*)(lds + 66560 + 16384);
    float v[8]; const float* p = FG + ((size_t)b * SEQ + 512 * w + 8 * lane) * 8 + h;
#pragma unroll
    for (int i = 0; i < 8; ++i) v[i] = p[i * 8];
    float run = 0.f;
#pragma unroll
    for (int i = 0; i < 8; ++i) { run += v[i]; v[i] = run; }
    float inc = run;
#pragma unroll
    for (int o = 1; o < 64; o <<= 1) { const float t_ = __shfl_up(inc, o); if (lane >= o) inc += t_; }
    if (lane == 63) wtot[w] = inc;
    LBAR();
    float base = inc - run;
    for (int w2 = 0; w2 < w; ++w2) base += wtot[w2];
#pragma unroll
    for (int i = 0; i < 8; ++i) cumL[512 * w + 8 * lane + i] = base + v[i];
    LBAR();
}
__device__ __forceinline__ void fox_unit(LAS unsigned char* lds, int b, int h, int qb, const bf16_t* __restrict__ Z, const bf16_t* __restrict__ VTg, bf16_t* __restrict__ O) {
    int tid = threadIdx.x; asm volatile("" : "+v"(tid)); const int lane = tid & 63, w = __builtin_amdgcn_readfirstlane(tid >> 6), fr = lane & 15, fq = lane >> 4;
    const LAS float* cum = (const LAS float*)(lds + 66560);
    const int q0 = qb * 256; const long rowb = (long)b * SEQ;
    const float cref = cum[q0];
    bf16x8 qf[2][4]; float cqs[2]; int qpos[2];
#pragma unroll
    for (int qt = 0; qt < 2; ++qt) { qpos[qt] = q0 + 32 * w + 16 * qt + fr; cqs[qt] = (cum[qpos[qt]] - cref) * LOG2E;
#pragma unroll
        for (int kk = 0; kk < 4; ++kk) qf[qt][kk] = *(const bf16x8*)(Z + (size_t)h * ZS + (size_t)(rowb + qpos[qt]) * 128 + 32 * kk + 8 * fq); }
    f32x4 ot[2][8];
#pragma unroll
    for (int qt = 0; qt < 2; ++qt)
#pragma unroll
        for (int i = 0; i < 8; ++i) ot[qt][i] = (f32x4){0.f, 0.f, 0.f, 0.f};
    float mrun[2] = {0.f, 0.f}, lrun[2] = {0.f, 0.f};
    const int ntile = 4 * qb + 4; const int wmax = q0 + 32 * w + 31;
    constexpr int KB_ = 16384, BUFB = 32768 + 256;
    const bf16_t* Kg = Z + (size_t)(8 + h) * ZS + (size_t)rowb * 128;
    const bf16_t* Vg = VTg + (size_t)(b * 8 + h) * 128 * SEQ;
    float cr = 0.f;
#define FOX_DMA(kt_, buf_) do { \
        _Pragma("unroll") for (int i = 0; i < 2; ++i) { const int j = 2 * w + i; const int row = 4 * j + (lane >> 4); const int c = (lane & 15) ^ (row & 15); \
            __builtin_amdgcn_global_load_lds((const unsigned*)(Kg + (size_t)(64 * (kt_) + row) * 128 + 8 * c), (LAS unsigned*)(lds + (buf_) * BUFB + j * 1024), 16, 0, 0); } \
        _Pragma("unroll") for (int i = 0; i < 2; ++i) { const int j = 2 * w + i; const int row = 8 * j + (lane >> 3); const int c = (lane & 7) ^ ((row >> 1) & 7); \
            __builtin_amdgcn_global_load_lds((const unsigned*)(Vg + (size_t)row * SEQ + 64 * (kt_) + 8 * c), (LAS unsigned*)(lds + (buf_) * BUFB + KB_ + j * 1024), 16, 0, 0); } \
        cr = cum[64 * (kt_) + lane]; } while (0)
#define FOX_CKS(buf_) do { if (tid < 64) ((LAS float*)(lds + (buf_) * BUFB + 32768))[tid] = (cr - cref) * LOG2E; } while (0)
    const int ka0 = fr * 256, va0 = KB_ + fr * 128;
    FOX_DMA(0, 0); FOX_CKS(0);
    asm volatile("s_waitcnt vmcnt(0)" ::: "memory");
    LBAR();
    for (int kt = 0; kt < ntile; ++kt) {
        const LAS unsigned char* Kb = lds + (kt & 1) * BUFB; const LAS float* cks = (const LAS float*)(Kb + 32768);
        if (kt + 1 < ntile) FOX_DMA(kt + 1, (kt + 1) & 1);
        if (64 * kt <= wmax) {
            const bool band = (64 * kt + 63 > q0 + 32 * w);
            f32x4 st[2][4]; const float cm0 = cqs[0] - mrun[0], cm1 = cqs[1] - mrun[1];
            bf16x8 kfr[2][4]; f32x4 ckr[2];
#pragma unroll
            for (int kk = 0; kk < 4; ++kk) kfr[0][kk] = *(const LAS bf16x8*)(Kb + ka0 + (((4 * kk + fq) ^ fr) << 4));
            ckr[0] = *(const LAS f32x4*)(cks + 4 * fq);
#pragma unroll
            for (int k16 = 0; k16 < 4; ++k16) {
                if (k16 < 3) {
#pragma unroll
                    for (int kk = 0; kk < 4; ++kk) kfr[(k16 + 1) & 1][kk] = *(const LAS bf16x8*)(Kb + (k16 + 1) * 4096 + ka0 + (((4 * kk + fq) ^ fr) << 4));
                    ckr[(k16 + 1) & 1] = *(const LAS f32x4*)(cks + 16 * (k16 + 1) + 4 * fq); }
                __builtin_amdgcn_sched_barrier(0);
                f32x4 a0 = cm0 - ckr[k16 & 1], a1 = cm1 - ckr[k16 & 1];
#pragma unroll
                for (int kk = 0; kk < 4; ++kk) { a0 = MFMA16(kfr[k16 & 1][kk], qf[0][kk], a0); a1 = MFMA16(kfr[k16 & 1][kk], qf[1][kk], a1); }
                st[0][k16] = a0; st[1][k16] = a1; }
            if (band) {
#pragma unroll
                for (int qt = 0; qt < 2; ++qt)
#pragma unroll
                    for (int k16 = 0; k16 < 4; ++k16)
#pragma unroll
                        for (int j = 0; j < 4; ++j) if (64 * kt + 16 * k16 + 4 * fq + j > qpos[qt]) st[qt][k16][j] = -INFINITY; }
            float mx[2];
#pragma unroll
            for (int qt = 0; qt < 2; ++qt) { float m_ = -INFINITY;
#pragma unroll
                for (int k16 = 0; k16 < 4; ++k16)
#pragma unroll
                    for (int j = 0; j < 4; ++j) m_ = fmaxf(m_, st[qt][k16][j]);
                m_ = fmaxf(m_, __shfl_xor(m_, 16)); m_ = fmaxf(m_, __shfl_xor(m_, 32)); mx[qt] = m_; }
            const bool first = (kt == 0);
            if (first || __any((mx[0] > 8.f) || (mx[1] > 8.f))) {
#pragma unroll
                for (int qt = 0; qt < 2; ++qt) { const float delta = first ? mx[qt] : fmaxf(mx[qt], 0.f); const float alpha = first ? 1.f : ex2(-delta); mrun[qt] += delta;
                    lrun[qt] *= alpha;
#pragma unroll
                    for (int et = 0; et < 8; ++et) ot[qt][et] = ot[qt][et] * alpha;
#pragma unroll
                    for (int k16 = 0; k16 < 4; ++k16) st[qt][k16] = st[qt][k16] - delta; } }
#pragma unroll
            for (int qt = 0; qt < 2; ++qt) { float ps = 0.f;
#pragma unroll
                for (int k16 = 0; k16 < 4; ++k16)
#pragma unroll
                    for (int j = 0; j < 4; ++j) { const float p = ex2(st[qt][k16][j]); st[qt][k16][j] = p; ps += p; }
                lrun[qt] += ps; }
            bf16x8 pf[2][2];
#pragma unroll
            for (int qt = 0; qt < 2; ++qt)
#pragma unroll
                for (int kb = 0; kb < 2; ++kb) { u32x4 pw; pw.x = pk2(st[qt][2 * kb][0], st[qt][2 * kb][1]); pw.y = pk2(st[qt][2 * kb][2], st[qt][2 * kb][3]);
                    pw.z = pk2(st[qt][2 * kb + 1][0], st[qt][2 * kb + 1][1]); pw.w = pk2(st[qt][2 * kb + 1][2], st[qt][2 * kb + 1][3]); pf[qt][kb] = __builtin_bit_cast(bf16x8, pw); }
            { bf16x8 vfr[2][2];
#pragma unroll
              for (int kb = 0; kb < 2; ++kb) vfr[0][kb] = *(const LAS bf16x8*)(Kb + va0 + (((4 * kb + fq) ^ (fr >> 1)) << 4));
#pragma unroll
              for (int et = 0; et < 8; ++et) {
                if (et < 7) {
#pragma unroll
                    for (int kb = 0; kb < 2; ++kb) vfr[(et + 1) & 1][kb] = *(const LAS bf16x8*)(Kb + (et + 1) * 2048 + va0 + (((4 * kb + fq) ^ (fr >> 1)) << 4)); }
                __builtin_amdgcn_sched_barrier(0);
#pragma unroll
                for (int kb = 0; kb < 2; ++kb) { ot[0][et] = MFMA16(vfr[et & 1][kb], pf[0][kb], ot[0][et]); ot[1][et] = MFMA16(vfr[et & 1][kb], pf[1][kb], ot[1][et]); } } }
        }
        if (kt + 1 < ntile) FOX_CKS((kt + 1) & 1);
        asm volatile("s_waitcnt vmcnt(0)" ::: "memory");
        LBAR();
    }
#undef FOX_DMA
#undef FOX_CKS
#pragma unroll
    for (int qt = 0; qt < 2; ++qt) { float l = lrun[qt]; l += __shfl_xor(l, 16); l += __shfl_xor(l, 32); const float inv = 1.f / l;
        const bf16_t* gp = Z + (size_t)(24 + h) * ZS + (size_t)(rowb + qpos[qt]) * 128 + 4 * fq;
        bf16_t* op = O + (size_t)(rowb + qpos[qt]) * DM + h * 128 + 4 * fq;
#pragma unroll
        for (int et = 0; et < 8; ++et) { const u32x2 gr = *(const u32x2*)(gp + 16 * et);
            const float g0 = sigmoidf_(bf2f((unsigned short)(gr.x & 0xffffu))), g1 = sigmoidf_(bf2f((unsigned short)(gr.x >> 16))), g2 = sigmoidf_(bf2f((unsigned short)(gr.y & 0xffffu))), g3 = sigmoidf_(bf2f((unsigned short)(gr.y >> 16)));
            u32x2 wv; wv.x = pk2(ot[qt][et][0] * inv * g0, ot[qt][et][1] * inv * g1); wv.y = pk2(ot[qt][et][2] * inv * g2, ot[qt][et][3] * inv * g3); *(u32x2*)(op + 16 * et) = wv; } }
}

#define XB_TMO      128
#define XB_XCNT(j)  (256  + 64 * (j))
#define XB_XSUB(j)  (1280 + 64 * (j))
#define XB_XGEN(j)  (2304 + 64 * (j))
#define XB_TOP      3328
#define XB_TOPGEN   3392
#define XCD_BAR_WORDS 3456
#define XB_SPIN_CAP (1u << 18)

__device__ __forceinline__ unsigned xb_ld(unsigned* p)              { return __hip_atomic_load(p, __ATOMIC_RELAXED, __HIP_MEMORY_SCOPE_AGENT); }
__device__ __forceinline__ unsigned xb_add(unsigned* p, unsigned v) { return __hip_atomic_fetch_add(p, v, __ATOMIC_RELAXED, __HIP_MEMORY_SCOPE_AGENT); }
__device__ __forceinline__ unsigned xb_xcc_id() { return (unsigned)__builtin_amdgcn_s_getreg((3 << 11) | 20) & 0xFu; }
#define XB_SPIN(cond, bar) do { unsigned _sp = 0; while (cond) { __builtin_amdgcn_s_sleep(1); \
    if ((++_sp & 255u) == 0u) { if (xb_ld(&(bar)[XB_TMO])) break; if (_sp > XB_SPIN_CAP) { atomicAdd(&(bar)[XB_TMO], 1u); break; } } } } while (0)

struct XcdBarrier {
    unsigned* bar; unsigned x;
    volatile LAS unsigned* st;
};

__device__ __forceinline__ XcdBarrier xcd_barrier_post(unsigned* bar, volatile LAS unsigned* st) {
    XcdBarrier b; b.bar = bar; b.x = xb_xcc_id(); b.st = st;
    if (threadIdx.x == 0) (void)xb_add(&bar[XB_XCNT(b.x)], 1u);
    return b;
}
__device__ __forceinline__ void xcd_barrier_complete(unsigned* bar, unsigned x, unsigned& nloc, unsigned& nx) {
    const unsigned G = gridDim.x * gridDim.y * gridDim.z;
    unsigned sum, cnt, mine, sp = 0u;
    for (;;) {
        sum = 0u; cnt = 0u; mine = 0u;
#pragma unroll
        for (unsigned j = 0; j < 16; ++j) { const unsigned c = xb_ld(&bar[XB_XCNT(j)]); sum += c; cnt += (c > 0u) ? 1u : 0u; mine = (j == x) ? c : mine; }
        if (sum == G) break;
        __builtin_amdgcn_s_sleep(1);
        if ((++sp & 255u) == 0u) { if (xb_ld(&bar[XB_TMO])) break; if (sp > XB_SPIN_CAP) { atomicAdd(&bar[XB_TMO], 1u); break; } }
    }
    nloc = mine > 0u ? mine : 1u; nx = cnt > 0u ? cnt : 1u;
}

__device__ __forceinline__ void xcd_barrier(const XcdBarrier& b) {
    asm volatile("s_waitcnt vmcnt(0)" ::: "memory");
    __syncthreads();
    int tl_ = threadIdx.x; asm volatile("" : "+v"(tl_));
    if (tl_ == 0) {
        unsigned* bar = b.bar;
        __builtin_amdgcn_s_waitcnt(0);
        unsigned nloc = b.st[0], nx = b.st[1];
        if (nloc == 0u) { xcd_barrier_complete(bar, b.x, nloc, nx); b.st[0] = nloc; b.st[1] = nx; }
        const unsigned old = xb_add(&bar[XB_XSUB(b.x)], 1u);
        const unsigned gen = old / nloc;
        if (old + 1u == (gen + 1u) * nloc) {
            __builtin_amdgcn_fence(__ATOMIC_RELEASE, "agent");
            asm volatile("s_waitcnt vmcnt(0)" ::: "memory");
            const unsigned og = xb_add(&bar[XB_TOP], 1u);
            const unsigned tg = og / nx;
            if (og + 1u == (tg + 1u) * nx) xb_add(&bar[XB_TOPGEN], 1u);
            else XB_SPIN(xb_ld(&bar[XB_TOPGEN]) == tg, bar);
            __builtin_amdgcn_fence(__ATOMIC_ACQUIRE, "agent");
            xb_add(&bar[XB_XGEN(b.x)], 1u);
            asm volatile("s_waitcnt vmcnt(0)" ::: "memory");
        } else {
            XB_SPIN(xb_ld(&bar[XB_XGEN(b.x)]) == gen, bar);
            __builtin_amdgcn_fence(__ATOMIC_ACQUIRE, "agent");
            asm volatile("s_waitcnt vmcnt(0)" ::: "memory");
        }
    }
    __syncthreads();
}

#define REP_SCAN1 1
#define REP_SCAN2 1
#define REP_P0 1
#define REP_N3 1
#define REP_G6X 0
#define REP_FOX 1
#define REP_G1 1
#define REP_XA 1
#define REP_SYNC 0
#define REP_G2 1
#ifndef PHM
#define PHM 0xffff
#endif
#ifndef DBG_STOP
#define DBG_STOP 6
#endif
struct Params { const float* in[24]; float* out; unsigned char* ws; };
__global__ void __launch_bounds__(512) mega_fwd(Params P) {
    extern __shared__ __attribute__((aligned(16))) unsigned char lds_raw[];
    LAS unsigned char* lds = (LAS unsigned char*)lds_raw;
    cg::grid_group grid = cg::this_grid();
    { volatile LAS unsigned* st0 = (volatile LAS unsigned*)(lds + 147440); if (threadIdx.x < 4) st0[threadIdx.x] = 0u; }
    __syncthreads();
    (void)xcd_barrier_post((unsigned*)(P.ws + 4096), (volatile LAS unsigned*)(lds + 147440));
#define GSYNC() do { XcdBarrier b_; b_.bar = (unsigned*)(P.ws + 4096); b_.x = xb_xcc_id(); b_.st = (volatile LAS unsigned*)(lds + 147440); xcd_barrier(b_); } while (0)
    const int tid = threadIdx.x, lane = tid & 63, wave = __builtin_amdgcn_readfirstlane(tid >> 6);
    const int G = gridDim.x, bx = blockIdx.x;
    const int gw = bx * 8 + wave, ngw = G * 8;
#define LANE_L() ({ int t_ = threadIdx.x; asm volatile("" : "+v"(t_)); t_ & 63; })
    unsigned char* ws = P.ws;
    const float* x = P.in[0];
    float* hres = P.out; bf16_t* R0 = (bf16_t*)P.out; bf16_t* R1 = R0 + (size_t)T * DM;
    float* G0 = (float*)(ws + WS_G0); float* FG = (float*)(ws + WS_FG); float* CUM = (float*)(ws + WS_CUM);
    bf16_t* MEMN = (bf16_t*)(ws + WS_MEMN); bf16_t* MEMKV = (bf16_t*)(ws + WS_MEMKV);
    bf16_t* Zb = (bf16_t*)(ws + WS_Z); bf16_t* A1 = (bf16_t*)(ws + WS_A1); bf16_t* A2 = (bf16_t*)(ws + WS_A2);
    bf16_t* WinA = (bf16_t*)(ws + W_INA); bf16_t* WinC = (bf16_t*)(ws + W_INC); bf16_t* WoutA = (bf16_t*)(ws + W_OUTA); bf16_t* WoutC = (bf16_t*)(ws + W_OUTC);
    bf16_t* Wkv = (bf16_t*)(ws + W_KV); bf16_t* W1 = (bf16_t*)(ws + W_1); bf16_t* W2 = (bf16_t*)(ws + W_2);

    float* RS = (float*)(ws + WS_RS);
    pg8::PG8F xsl = (pg8::PG8F)(lds + 131072);
#pragma unroll 1
    for (int rep_ = 0; rep_ < REP_P0; ++rep_) {
        LAS float* scr = (LAS float*)(lds + wave * 16384);
        { const int ln_ = LANE_L();
#define TJOB(W_, K_, pitch_, ncols_, gapat_, gap_, WT_, gk_) { constexpr int nblk_ = (ncols_) / 32, items_ = ((K_) / 64) * nblk_; \
            if (r_ < items_) { const int kb_ = r_ / nblk_, n0_ = 32 * (r_ % nblk_); transpose_item(W_, K_, pitch_, n0_ + (n0_ >= (gapat_) ? (gap_) : 0), WT_, n0_, scr, kb_, ln_, gk_); continue; } r_ -= items_; }
          constexpr int NITEMS_P0 = 2 * 2048 + 2 * 512 + 1024 + 4 * 512 + 2 * 2048;
#pragma unroll 1
          for (int it = gw; it < NITEMS_P0; it += ngw) { int r_ = it;
            TJOB(P.in[6], 1024, 4104, 4096, 2048, 8, WinA, nullptr)
            TJOB(P.in[13], 1024, 4104, 4096, 1 << 30, 0, WinC, P.in[2] + 1024)
            TJOB(P.in[22], 1024, 4096, 4096, 1 << 30, 0, W1, P.in[4])
            TJOB(P.in[23], 4096, 1024, 1024, 1 << 30, 0, W2, nullptr)
            TJOB(P.in[19], 1024, 2048, 2048, 1 << 30, 0, Wkv, nullptr)
            TJOB(P.in[12], 1024, 1024, 1024, 1 << 30, 0, WoutA, nullptr)
            TJOB(P.in[17], 1024, 1024, 1024, 1 << 30, 0, WoutC, nullptr)
            TJOB(P.in[20], 1024, 1024, 1024, 1 << 30, 0, (bf16_t*)(ws + W_Q0), P.in[3])
            TJOB(P.in[20] + 1024 * 1024, 1024, 1024, 1024, 1 << 30, 0, (bf16_t*)(ws + W_Q1), P.in[3] + 1024)
            TJOB(P.in[21], 1024, 1024, 1024, 1 << 30, 0, (bf16_t*)(ws + W_O0), nullptr)
            TJOB(P.in[21] + 1024 * 1024, 1024, 1024, 1024, 1 << 30, 0, (bf16_t*)(ws + W_O1), nullptr)
          }
#undef TJOB
        }
        __syncthreads();
        stage_gate_w(P.in[6], 4104, 2048, (LAS float*)lds);
        __syncthreads();
        norm_rows<false, 1>(x, P.in[2], A1, T, gw, ngw, LANE_L(), (const LAS float*)lds, P.in[8], G0);
        norm_rows<false, 0>(P.in[1], P.in[18], MEMN, 1024, gw, ngw, LANE_L(), (const LAS float*)lds, nullptr, nullptr);
        __syncthreads();
    }
    GSYNC();
    if (P.ws == nullptr) grid.sync();
#pragma unroll 1
    for (int rep_ = 0; rep_ < REP_G1; ++rep_)
    { pg8::Gemm g{A1, WinA, T, 4096, 1024}; pg8::StaticOrder S; S.init(T, 4096, G, bx);
      pg8::EpiBf16<0> E{Zb, ZW, 1.f, nullptr, (size_t)ZS}; pg8::gemm_phase<pg8::EpiBf16<0>, pg8::StaticOrder, true, true>(lds, g, S, E); }
    GSYNC();
    { const int mixer = bx >> 7, r = bx & 127, sb = r >> 5, sh = (r >> 3) & 3, sg = r & 7;
      float* LOC = (float*)(ws + WS_A1); float* VEC = (float*)(ws + WS_VEC); const float* MS = (const float*)(ws + WS_MS); const float* DCG = (const float*)(ws + WS_DCG);
      if (sg == 7) {
        pg8::Gemm g{MEMN, Wkv, 1024, 2048, 1024}; pg8::StaticOrder S; S.init(1024, 2048, 32, bx >> 3);
        pg8::EpiBf16<0> E{MEMKV, 2048, 1.f, nullptr, 0}; pg8::gemm_phase<pg8::EpiBf16<0>, pg8::StaticOrder, true, true>(lds, g, S, E); }
#pragma unroll 1
      for (int rep_ = 0; rep_ < REP_SCAN1; ++rep_)
      if (G == 256) {
        if (mixer == 0 && sg != 7) { if (wave == 0) mlstm_prescan(G0, (float*)(ws + WS_MS), (float*)(ws + WS_DCG), sb * 4 + sh, LANE_L()); __syncthreads(); }
        if (mixer == 0) scan_group<true, false>(lds, sb, sh, sg, bx, Zb, G0, P.in[7], nullptr, P.in[10], A2, LOC, VEC, MS, DCG);
        else scan_group<false, false>(lds, sb, sh, sg, bx, Zb, nullptr, nullptr, P.in[9], P.in[11], A2, LOC, VEC, MS, DCG);
      }
      GSYNC();
#pragma unroll 1
      for (int rep_ = 0; rep_ < REP_SCAN2; ++rep_)
      if (G == 256) {
        if (mixer == 0) scan_group<true, true>(lds, sb, sh, sg, bx, Zb, G0, P.in[7], nullptr, P.in[10], A2, LOC, VEC, MS, DCG);
        else scan_group<false, true>(lds, sb, sh, sg, bx, Zb, nullptr, nullptr, P.in[9], P.in[11], A2, LOC, VEC, MS, DCG);
      } }
    GSYNC();
#pragma unroll 1
    for (int rep_ = 0; rep_ < REP_G2; ++rep_)
    { pg8::Gemm g{A2, WoutA, T, 1024, 1024}; pg8::StaticOrder S; S.init(T, 1024, G, bx);
      pg8::EpiResB E{x, 1, R0, RS, xsl}; pg8::gemm_phase<pg8::EpiResB, pg8::StaticOrder, true, true>(lds, g, S, E); }
    xattn_vt_prep(MEMKV, MEMN, bx * 512 + tid);
    GSYNC();
#pragma unroll
    for (int layer = 0; layer < 2; ++layer) {
        if (layer == 1) {
            { LAS float* scr = (LAS float*)(lds + wave * 16384);
              { const int ln_ = LANE_L();
#define TJOB(W_, K_, pitch_, ncols_, WT_, gk_) { constexpr int nblk_ = (ncols_) / 32, items_ = ((K_) / 64) * nblk_; \
                if (r_ < items_) { const int kb_ = r_ / nblk_, n0_ = 32 * (r_ % nblk_); transpose_item(W_, K_, pitch_, n0_, WT_, n0_, scr, kb_, ln_, gk_); continue; } r_ -= items_; }
#pragma unroll 1
                for (int it = gw; it < 4096; it += ngw) { int r_ = it;
                  TJOB(P.in[22] + (size_t)1024 * 4096, 1024, 4096, 4096, W1, P.in[4] + 1024)
                  TJOB(P.in[23] + (size_t)1024 * 4096, 4096, 1024, 1024, W2, nullptr) }
#undef TJOB
              }
              __syncthreads();
              stage_gate_w(P.in[13], 4104, 4096, (LAS float*)lds);
              __syncthreads();
              norm_rows<false, 2, true, true>(R0, P.in[2] + 1024, nullptr, T, gw, ngw, LANE_L(), (const LAS float*)lds, P.in[14], FG); __syncthreads(); }
            { pg8::Gemm g{R0, WinC, T, 4096, 1024}; pg8::StaticOrder S; S.init(T, 4096, G, bx);
              pg8::EpiZ1 E{Zb, (size_t)ZS, P.in[15], P.in[16], xsl, A2, RS + 4 * 4 * T}; pg8::gemm_phase<pg8::EpiZ1, pg8::StaticOrder, true, true>(lds, g, S, E); }
            GSYNC();
#pragma unroll 1
            for (int rep_ = 0; rep_ < REP_FOX; ++rep_)
            for (int u = bx; u < 256; u += G) {
                const int xcd_ = u & 7, li_ = u >> 3; const int bh = xcd_ * 4 + (li_ >> 3), pr = li_ & 7;
                fox_cumsum_lds(lds, FG, bh >> 3, bh & 7);
#pragma unroll 1
                for (int hf = 0; hf < 2; ++hf) fox_unit(lds, bh >> 3, bh & 7, hf ? pr : 15 - pr, Zb, A2, A1); }
            GSYNC();
            { pg8::Gemm g{A1, WoutC, T, 1024, 1024}; pg8::StaticOrder S; S.init(T, 1024, G, bx);
              pg8::EpiResB E{R0, 0, R1, RS + 2 * 4 * T, xsl}; pg8::gemm_phase<pg8::EpiResB, pg8::StaticOrder, true, true>(lds, g, S, E); }
            GSYNC();
        }
        bf16_t* Rin = layer ? R1 : R0; bf16_t* Rmid = layer ? A2 : R1; bf16_t* Rout = R0;
        { pg8::Gemm g{Rin, (bf16_t*)(ws + (layer ? W_Q1 : W_Q0)), T, 1024, 1024}; pg8::StaticOrder S; S.init(T, 1024, G, bx);
          pg8::EpiBf16<0> E{A2, DM, 0.0625f * LOG2E, RS + (2 * layer) * 4 * T, 0}; pg8::gemm_phase<pg8::EpiBf16<0>, pg8::StaticOrder, true, true>(lds, g, S, E);
          __syncthreads();
          { pg8::StaticOrder S2; S2.init(T, 1024, G, bx); pg8::Unit un;
#pragma unroll 1
            for (int i = 0; S2.next(i, un); ++i) xattn_phase(lds, A2, MEMKV, MEMN, A1, 2 * un.pm, un.pn); } }
        GSYNC();
        { pg8::Gemm g{A1, (bf16_t*)(ws + (layer ? W_O1 : W_O0)), T, 1024, 1024}; pg8::StaticOrder S; S.init(T, 1024, G, bx);
          pg8::EpiResB E{Rin, 0, Rmid, RS + (2 * layer + 1) * 4 * T, xsl}; pg8::gemm_phase<pg8::EpiResB, pg8::StaticOrder, true, true>(lds, g, S, E); }
        GSYNC();
        { pg8::Gemm g{Rmid, W1, T, FF, 1024}; pg8::StaticOrder S; S.init(T, FF, G, bx);
          pg8::EpiBf16<2> E{Zb, FF, 1.f, RS + (2 * layer + 1) * 4 * T, 0}; pg8::gemm_phase<pg8::EpiBf16<2>, pg8::StaticOrder, true, true>(lds, g, S, E); }
        GSYNC();
#pragma unroll 1
        for (int rep_ = 0; rep_ < REP_G6X; ++rep_)
        { pg8::Gemm g{Zb, W2, T, 1024, FF}; pg8::StaticOrder S; S.init(T, 1024, G, bx);
          pg8::EpiBf16<0> E{A1, DM, 1.f, nullptr, 0}; pg8::gemm_phase<pg8::EpiBf16<0>, pg8::StaticOrder, true, true>(lds, g, S, E); }
        { pg8::Gemm g{Zb, W2, T, 1024, FF}; pg8::StaticOrder S; S.init(T, 1024, G, bx);
          if (layer == 0) { pg8::EpiResB E{Rmid, 0, Rout, RS + 4 * 4 * T, xsl}; pg8::gemm_phase<pg8::EpiResB, pg8::StaticOrder, true, true>(lds, g, S, E); }
          else { pg8::EpiResFinal E{Rmid, hres, P.in[5], RS + 4 * 4 * T, (unsigned*)(ws + 32768), xsl}; pg8::gemm_phase<pg8::EpiResFinal, pg8::StaticOrder, true, true>(lds, g, S, E); } }
        if (layer == 0) GSYNC();
    }
}

extern "C" void kernel_launch(void* const* d_in, const int* in_sizes, int n_in, void* d_out, int out_size, void* d_ws, size_t ws_size, hipStream_t stream) {
    static int grid = 0;
    if (grid == 0) {
        if (n_in != 24 || out_size != T * DM || ws_size < ((size_t)254 << 20)) { fprintf(stderr, "kernel_launch: unexpected problem (n_in %d out %d ws %zu)\n", n_in, out_size, ws_size); grid = -1; return; }
        int dev = 0, cus = 0, per_cu = 0;
        hipGetDevice(&dev); hipDeviceGetAttribute(&cus, hipDeviceAttributeMultiprocessorCount, dev);
        if (hipFuncSetAttribute((const void*)mega_fwd, hipFuncAttributeMaxDynamicSharedMemorySize, LDS_BYTES) != hipSuccess) { fprintf(stderr, "hipFuncSetAttribute failed\n"); grid = -1; return; }
        if (hipOccupancyMaxActiveBlocksPerMultiprocessor(&per_cu, (const void*)mega_fwd, 512, LDS_BYTES) != hipSuccess || per_cu < 1) { fprintf(stderr, "occupancy query: %d\n", per_cu); per_cu = 1; }
        (void)hipGetLastError();
        grid = cus * per_cu;
    }
    if (grid < 0) return;
    if (hipMemsetAsync((char*)d_ws, 0, 65536, stream) != hipSuccess) { fprintf(stderr, "memset failed\n"); return; }
    Params p{};
    for (int i = 0; i < 24; ++i) p.in[i] = (const float*)d_in[i];
    p.out = (float*)d_out; p.ws = (unsigned char*)d_ws;
    void* args[] = {&p};
    hipError_t e = hipLaunchCooperativeKernel((const void*)mega_fwd, dim3(grid), dim3(512), args, LDS_BYTES, stream);
    if (e != hipSuccess) fprintf(stderr, "cooperative launch failed: %s (grid %d)\n", hipGetErrorString(e), grid);
}
```

```cpp
#include <hip/hip_runtime.h>
#include <hip/hip_cooperative_groups.h>
#include <cstdio>
#include <cstdint>
namespace cg = cooperative_groups;
namespace pg8 {
#define PG8_LAS __attribute__((address_space(3)))
typedef unsigned short bf16_t;
typedef short bf16x8 __attribute__((ext_vector_type(8)));
typedef float f32x4 __attribute__((ext_vector_type(4)));
typedef unsigned u32x4 __attribute__((ext_vector_type(4)));
constexpr int BM = 256, BK = 64, HALF = 128, HTB = HALF * BK * 2  , STAGE_BYTES = 8 * HTB, NXCD = 8, WGM = 4;

__host__ __device__ __forceinline__ int lds_byte(int r, int c) { const int st = (r >> 4) * 2 + (c >> 5), rr = r & 15, cc = c & 31, ob = rr * 64 + cc * 2; return st * 1024 + (ob ^ (((ob >> 9) & 1) << 5)); }
__host__ __device__ __forceinline__ void stage_rc(int b, int& R, int& C) { const int st = b / 1024, sb = b % 1024, swz = sb ^ (((sb >> 9) & 1) << 5); R = (st >> 1) * 16 + swz / 64; C = (st & 1) * 32 + (swz % 64) / 2; }
__host__ __device__ __forceinline__ int perm32(int rho) { const int n = rho >> 4, i = rho & 15; return 8 * (i >> 2) + 4 * n + (i & 3); }

typedef PG8_LAS float* PG8F;
struct Unit { int pm, pn; };
struct Gemm { const bf16_t* A; const bf16_t* Bt; int M, N, K; };

struct StaticOrder {
    int nM, nN, nwg, G, c;
    __host__ __device__ __forceinline__ void init(int M, int N, int G_, int c_) { nM = M / BM; nN = N / BM; nwg = nM * nN; G = G_; c = c_; }
    __host__ __device__ __forceinline__ bool next(int i, Unit& u) const {
        const long L = (long)i * G + c; if (L >= nwg) return false;
        int wgid = (int)L; { const int q = nwg / NXCD, r = nwg % NXCD, xcd = wgid % NXCD, off = wgid / NXCD; wgid = (xcd < r ? xcd * (q + 1) : r * (q + 1) + (xcd - r) * q) + off; }
        const int nig = WGM * nN, gid = wgid / nig, fm = gid * WGM, gsz = (nM - fm) < WGM ? (nM - fm) : WGM;
        u.pm = fm + ((wgid % nig) % gsz); u.pn = (wgid % nig) / gsz; return true;
    }
    __device__ __forceinline__ void a_ready(const Unit&) const {}
    __device__ __forceinline__ void done(const Unit&) const {}
};

typedef float f32x2c __attribute__((ext_vector_type(2))); typedef __bf16 bf16x2c __attribute__((ext_vector_type(2)));
__device__ __forceinline__ unsigned cvt_pk_bf16(float lo, float hi) { const f32x2c v = {lo, hi}; return __builtin_bit_cast(unsigned, __builtin_convertvector(v, bf16x2c)); }
template <int ACT  > struct EpiBf16 {
    static constexpr bool PERM = true, AFTER_DRAIN = false;
    bf16_t* O; int ldc; float scale; const float* rs; size_t slot_stride;
    __device__ __forceinline__ void operator()(const f32x4 (&acc)[2][2][4][2], const Unit& u, int wr, int wc, int fr, int fq) const {
        const int row0 = u.pm * BM + wr * 64 + fr; const int col0 = u.pn * BM + wc * 32 + 8 * fq;
#pragma unroll
        for (int ai = 0; ai < 2; ++ai)
#pragma unroll
            for (int m = 0; m < 4; ++m) { bf16_t* rowp = slot_stride ? O + (size_t)(2 * u.pn) * slot_stride + (size_t)(row0 + ai * HALF + m * 16) * 128 + wc * 32 + 8 * fq : O + (size_t)(row0 + ai * HALF + m * 16) * ldc + col0;
                float rsc = 1.f; if (rs) { const f32x4 p4 = *(const f32x4*)(rs + (size_t)(row0 + ai * HALF + m * 16) * 4); rsc = __builtin_amdgcn_rsqf(((p4[0] + p4[1]) + (p4[2] + p4[3])) * (1.f / 1024.f) + 1e-6f); }
#pragma unroll
                for (int bj = 0; bj < 2; ++bj) { f32x4 v0 = acc[ai][bj][m][0] * rsc, v1 = acc[ai][bj][m][1] * rsc;
                    if (ACT == 2) {
#pragma unroll
                        for (int e = 0; e < 4; ++e) { float a = v0[e] > 0.f ? v0[e] : 0.f; v0[e] = a * a; float b = v1[e] > 0.f ? v1[e] : 0.f; v1[e] = b * b; } }
                    v0 = v0 * scale; v1 = v1 * scale; u32x4 w; w.x = cvt_pk_bf16(v0[0], v0[1]); w.y = cvt_pk_bf16(v0[2], v0[3]); w.z = cvt_pk_bf16(v1[0], v1[1]); w.w = cvt_pk_bf16(v1[2], v1[3]);
                    *(u32x4*)(rowp + (slot_stride ? bj * slot_stride : (size_t)(bj * HALF))) = w; } }
    }
};
struct EpiResF32 {
    static constexpr bool PERM = false, AFTER_DRAIN = false;
    const float* base; float* out; int ldc; bf16_t* hb; float* rs; PG8_LAS float* xs;
    __device__ __forceinline__ void operator()(const f32x4 (&acc)[2][2][4][2], const Unit& u, int wr, int wc, int fr, int fq) const {
        const int col0 = u.pn * BM + wc * 32 + 4 * fq;
#pragma unroll
        for (int ai = 0; ai < 2; ++ai)
#pragma unroll
            for (int m = 0; m < 4; ++m) { const size_t off = (size_t)(u.pm * BM + ai * HALF + wr * 64 + m * 16 + fr) * ldc + col0; float ssq = 0.f;
#pragma unroll
                for (int bj = 0; bj < 2; ++bj)
#pragma unroll
                    for (int n = 0; n < 2; ++n) { const f32x4 bs = *(const f32x4*)(base + off + bj * HALF + n * 16); const f32x4 v = bs + acc[ai][bj][m][n]; *(f32x4*)(out + off + bj * HALF + n * 16) = v;
                        if (hb) { ssq += (v[0] * v[0] + v[1] * v[1]) + (v[2] * v[2] + v[3] * v[3]); typedef unsigned u32x2_ __attribute__((ext_vector_type(2))); u32x2_ w; w.x = cvt_pk_bf16(v[0], v[1]); w.y = cvt_pk_bf16(v[2], v[3]); *(u32x2_*)(hb + off + bj * HALF + n * 16) = w; } }
                if (hb) { ssq += __shfl_xor(ssq, 16); ssq += __shfl_xor(ssq, 32); if (fq == 0) xs[(ai * HALF + wr * 64 + m * 16 + fr) * 4 + wc] = ssq; } }
        if (hb) {
            asm volatile("s_waitcnt lgkmcnt(0)\n\ts_barrier" ::: "memory");
            const int t_ = (wr * 4 + wc) * 64 + fq * 16 + fr;
            if (t_ < 256) { const f32x4 p4 = *(const PG8_LAS f32x4*)(xs + t_ * 4); rs[(size_t)(u.pm * BM + t_) * 4 + u.pn] = (p4[0] + p4[1]) + (p4[2] + p4[3]); } }
    }
};

struct EpiZ1 {
    static constexpr bool PERM = true, AFTER_DRAIN = false;
    bf16_t* O; size_t slot_stride; const float* gq; const float* gk; PG8_LAS float* xs; bf16_t* Vt; const float* rs;
    __device__ __forceinline__ void operator()(f32x4 (&acc)[2][2][4][2], const Unit& u, int wr, int wc, int fr, int fq) const {
        const int row0 = u.pm * BM + wr * 64 + fr; const bool qk = u.pn < 8; const bool isv = (u.pn >= 8 && u.pn < 12);
#pragma unroll
        for (int ai = 0; ai < 2; ++ai)
#pragma unroll
            for (int m = 0; m < 4; ++m) { const f32x4 p4 = *(const f32x4*)(rs + (size_t)(row0 + ai * HALF + m * 16) * 4);
                const float r_ = __builtin_amdgcn_rsqf(((p4[0] + p4[1]) + (p4[2] + p4[3])) * (1.f / 1024.f) + 1e-6f);
#pragma unroll
                for (int bj = 0; bj < 2; ++bj) { acc[ai][bj][m][0] = acc[ai][bj][m][0] * r_; acc[ai][bj][m][1] = acc[ai][bj][m][1] * r_; } }
        if (qk) {
#pragma unroll
            for (int ai = 0; ai < 2; ++ai)
#pragma unroll
                for (int m = 0; m < 4; ++m)
#pragma unroll
                    for (int bj = 0; bj < 2; ++bj) { const f32x4 v0 = acc[ai][bj][m][0], v1 = acc[ai][bj][m][1];
                        float s = ((v0[0] * v0[0] + v0[1] * v0[1]) + (v0[2] * v0[2] + v0[3] * v0[3])) + ((v1[0] * v1[0] + v1[1] * v1[1]) + (v1[2] * v1[2] + v1[3] * v1[3]));
                        s += __shfl_xor(s, 16); s += __shfl_xor(s, 32);
                        if (fq == 0) xs[((ai * HALF + wr * 64 + m * 16 + fr) * 2 + bj) * 4 + wc] = s; }
        }
        asm volatile("s_waitcnt lgkmcnt(0)\n\ts_barrier" ::: "memory");
        f32x4 gv[2][2];
        if (qk) { const float* gp = (u.pn < 4 ? gq : gk) + wc * 32 + 8 * fq; const float sc = u.pn < 4 ? 0.08838834764831845f * 1.4426950408889634f : 1.f;
#pragma unroll
            for (int bj = 0; bj < 2; ++bj) { gv[bj][0] = *(const f32x4*)gp * sc; gv[bj][1] = *(const f32x4*)(gp + 4) * sc; } }
#pragma unroll
        for (int ai = 0; ai < 2; ++ai)
#pragma unroll
            for (int m = 0; m < 4; ++m) { bf16_t* rowp = O + (size_t)(2 * u.pn) * slot_stride + (size_t)(row0 + ai * HALF + m * 16) * 128 + wc * 32 + 8 * fq;
#pragma unroll
                for (int bj = 0; bj < 2; ++bj) { f32x4 v0 = acc[ai][bj][m][0], v1 = acc[ai][bj][m][1];
                    if (qk) { const f32x4 p4 = *(const PG8_LAS f32x4*)(xs + ((ai * HALF + wr * 64 + m * 16 + fr) * 2 + bj) * 4);
                        const float r = __builtin_amdgcn_rsqf(((p4[0] + p4[1]) + (p4[2] + p4[3])) * (1.f / 128.f) + 1e-6f); v0 = v0 * r * gv[bj][0]; v1 = v1 * r * gv[bj][1]; }
                    u32x4 w; w.x = cvt_pk_bf16(v0[0], v0[1]); w.y = cvt_pk_bf16(v0[2], v0[3]); w.z = cvt_pk_bf16(v1[0], v1[1]); w.w = cvt_pk_bf16(v1[2], v1[3]);
                    if (isv) { const int row = row0 + ai * HALF + m * 16; const int bb = row >> 12, pos = row & 4095; const int hh = 2 * u.pn + bj - 16;
                        const int pk = (pos & ~63) + 32 * ((pos >> 5) & 1) + 8 * ((pos >> 2) & 3) + 4 * ((pos >> 4) & 1) + (pos & 3);
                        bf16_t* vp = Vt + ((size_t)(bb * 8 + hh) * 128 + wc * 32 + 8 * fq) * 4096 + pk; const unsigned ww[4] = {w.x, w.y, w.z, w.w};
#pragma unroll
                        for (int e = 0; e < 8; ++e) { *vp = (bf16_t)((e & 1) ? (ww[e >> 1] >> 16) : (ww[e >> 1] & 0xffffu)); vp += 4096; asm volatile("" : "+v"(vp)); } }
                    else *(u32x4*)(rowp + bj * slot_stride) = w; } }
    }
};
struct EpiResB {
    static constexpr bool PERM = true, AFTER_DRAIN = false;
    const void* base; int base_f32; bf16_t* out; float* rs; PG8_LAS float* xs;
    __device__ __forceinline__ void operator()(const f32x4 (&acc)[2][2][4][2], const Unit& u, int wr, int wc, int fr, int fq) const {
        const int row0 = u.pm * BM + wr * 64 + fr; const int col0 = u.pn * BM + wc * 32 + 8 * fq;
#pragma unroll
        for (int ai = 0; ai < 2; ++ai)
#pragma unroll
            for (int m = 0; m < 4; ++m) { const size_t off = (size_t)(row0 + ai * HALF + m * 16) * 1024 + col0; float ssq = 0.f;
#pragma unroll
                for (int bj = 0; bj < 2; ++bj) { f32x4 v0 = acc[ai][bj][m][0], v1 = acc[ai][bj][m][1];
                    if (base_f32) { const float* bp = (const float*)base + off + bj * HALF; v0 += *(const f32x4*)bp; v1 += *(const f32x4*)(bp + 4); }
                    else { const u32x4 r = *(const u32x4*)((const bf16_t*)base + off + bj * HALF);
                        v0 += (f32x4){__uint_as_float(r.x << 16), __uint_as_float(r.x & 0xffff0000u), __uint_as_float(r.y << 16), __uint_as_float(r.y & 0xffff0000u)};
                        v1 += (f32x4){__uint_as_float(r.z << 16), __uint_as_float(r.z & 0xffff0000u), __uint_as_float(r.w << 16), __uint_as_float(r.w & 0xffff0000u)}; }
                    u32x4 w; w.x = cvt_pk_bf16(v0[0], v0[1]); w.y = cvt_pk_bf16(v0[2], v0[3]); w.z = cvt_pk_bf16(v1[0], v1[1]); w.w = cvt_pk_bf16(v1[2], v1[3]);
                    *(u32x4*)(out + off + bj * HALF) = w;
                    if (rs) ssq += ((v0[0] * v0[0] + v0[1] * v0[1]) + (v0[2] * v0[2] + v0[3] * v0[3])) + ((v1[0] * v1[0] + v1[1] * v1[1]) + (v1[2] * v1[2] + v1[3] * v1[3])); }
                if (rs) { ssq += __shfl_xor(ssq, 16); ssq += __shfl_xor(ssq, 32); if (fq == 0) xs[(ai * HALF + wr * 64 + m * 16 + fr) * 4 + wc] = ssq; }
                if (base_f32 && (m & 1)) asm volatile("" ::: "memory"); }
        if (rs) {
            asm volatile("s_waitcnt lgkmcnt(0)\n\ts_barrier" ::: "memory");
            const int t_ = (wr * 4 + wc) * 64 + fq * 16 + fr;
            if (t_ < 256) { const f32x4 p4 = *(const PG8_LAS f32x4*)(xs + t_ * 4); rs[(size_t)(u.pm * BM + t_) * 4 + u.pn] = (p4[0] + p4[1]) + (p4[2] + p4[3]); } }
    }
};

struct EpiResFinal {
    static constexpr bool PERM = false, AFTER_DRAIN = false;
    const bf16_t* base; float* out; const float* gfin; float* xbuf; unsigned* cnt; PG8_LAS float* xs;
    __device__ __forceinline__ void operator()(f32x4 (&acc)[2][2][4][2], const Unit& u, int wr, int wc, int fr, int fq) const {
        const int col0 = u.pn * BM + wc * 32 + 4 * fq;
#pragma unroll
        for (int ai = 0; ai < 2; ++ai)
#pragma unroll
            for (int m = 0; m < 4; ++m) { const size_t off = (size_t)(u.pm * BM + ai * HALF + wr * 64 + m * 16 + fr) * 1024 + col0; float ssq = 0.f;
#pragma unroll
                for (int bj = 0; bj < 2; ++bj)
#pragma unroll
                    for (int n = 0; n < 2; ++n) { typedef unsigned u32x2_ __attribute__((ext_vector_type(2))); const u32x2_ r = *(const u32x2_*)(base + off + bj * HALF + n * 16);
                        f32x4 v = acc[ai][bj][m][n] + (f32x4){__uint_as_float(r.x << 16), __uint_as_float(r.x & 0xffff0000u), __uint_as_float(r.y << 16), __uint_as_float(r.y & 0xffff0000u)};
                        acc[ai][bj][m][n] = v; ssq += (v[0] * v[0] + v[1] * v[1]) + (v[2] * v[2] + v[3] * v[3]); }
                ssq += __shfl_xor(ssq, 16); ssq += __shfl_xor(ssq, 32); if (fq == 0) xs[(ai * HALF + wr * 64 + m * 16 + fr) * 4 + wc] = ssq; }
        asm volatile("s_waitcnt lgkmcnt(0)\n\ts_barrier" ::: "memory");
        const int wid = wr * 4 + wc, t_ = wid * 64 + fq * 16 + fr;
        if (t_ < 256) { const f32x4 p4 = *(const PG8_LAS f32x4*)(xs + t_ * 4);
            __hip_atomic_store(xbuf + (size_t)(u.pm * BM + t_) * 4 + u.pn, (p4[0] + p4[1]) + (p4[2] + p4[3]), __ATOMIC_RELAXED, __HIP_MEMORY_SCOPE_AGENT); }
        asm volatile("s_waitcnt vmcnt(0)" ::: "memory");
        if (wid < 4 && fq == 0 && fr == 0) __hip_atomic_fetch_add(cnt + 64 * u.pm, 1u, __ATOMIC_RELAXED, __HIP_MEMORY_SCOPE_AGENT);
        if (wid == 0) { unsigned sp = 0;
            while ((unsigned)__builtin_amdgcn_readfirstlane(__hip_atomic_load(cnt + 64 * u.pm, __ATOMIC_RELAXED, __HIP_MEMORY_SCOPE_AGENT)) < 16u) { __builtin_amdgcn_s_sleep(2); if (++sp > (1u << 22)) break; }
            __builtin_amdgcn_fence(__ATOMIC_ACQUIRE, "agent"); }
        asm volatile("s_waitcnt vmcnt(0) lgkmcnt(0)\n\ts_barrier" ::: "memory");
        f32x4 gv[2][2];
#pragma unroll
        for (int bj = 0; bj < 2; ++bj)
#pragma unroll
            for (int n = 0; n < 2; ++n) gv[bj][n] = *(const f32x4*)(gfin + col0 + bj * HALF + n * 16);
#pragma unroll
        for (int ai = 0; ai < 2; ++ai)
#pragma unroll
            for (int m = 0; m < 4; ++m) { const int row = u.pm * BM + ai * HALF + wr * 64 + m * 16 + fr; const size_t off = (size_t)row * 1024 + col0; float s = 0.f;
#pragma unroll
                for (int t = 0; t < 4; ++t) s += __hip_atomic_load(xbuf + (size_t)row * 4 + t, __ATOMIC_RELAXED, __HIP_MEMORY_SCOPE_AGENT);
                const float rstd = __builtin_amdgcn_rsqf(s * (1.f / 1024.f) + 1e-6f);
#pragma unroll
                for (int bj = 0; bj < 2; ++bj)
#pragma unroll
                    for (int n = 0; n < 2; ++n) *(f32x4*)(out + off + bj * HALF + n * 16) = acc[ai][bj][m][n] * rstd * gv[bj][n]; }
    }
};

template <class Epi, class Sched, bool ALIGN_EPI = false, bool SP2 = false>
__device__ __forceinline__ void gemm_phase(PG8_LAS unsigned char* lds, const Gemm g, const Sched& S, const Epi& E) {
    int tid = threadIdx.x; asm volatile("" : "+v"(tid)); const int wid = __builtin_amdgcn_readfirstlane(tid >> 6), lane = tid & 63, wr = wid >> 2, wc = wid & 3, fr = lane & 15, fq = lane >> 4;
    const int K = g.K, nt = K / BK;
    unsigned voffA[2], voffB[2];
#pragma unroll
    for (int i = 0; i < 2; ++i) { int R, C; stage_rc(tid * 16 + i * 8192, R, C); const int Rb = Epi::PERM ? ((R & ~31) + perm32(R & 31)) : R;
        voffA[i] = (unsigned)(R * K + C) * 2u; voffB[i] = (unsigned)(Rb * K + C) * 2u; }
    const size_t kstep = (size_t)(BK * 2);
    const size_t hstep = (size_t)HALF * K * 2;
    const size_t tstep = 2 * hstep;
    const unsigned ldsw = (unsigned)wid * 1024u;
    const int aoff = lds_byte(wr * 64 + fr, fq * 8), boff = lds_byte(wc * 32 + fr, fq * 8);
#define PG8_SA(b, h) (((b) * 2 + (h)) * HTB)
#define PG8_SB(b, h) ((4 + (b) * 2 + (h)) * HTB)
#define PG8_STAGE(bufoff, gbase, voff) do { _Pragma("unroll") for (int _i = 0; _i < 2; ++_i) \
        __builtin_amdgcn_global_load_lds((const unsigned*)((const char*)(gbase) + (voff)[_i]), (PG8_LAS unsigned*)(lds + (bufoff) + ldsw + _i * 8192), 16, 0, 0); } while (0)
#define PG8_LDA(dst, b, h) do { _Pragma("unroll") for (int m = 0; m < 4; ++m) _Pragma("unroll") for (int k = 0; k < 2; ++k) dst[m][k] = *(const PG8_LAS bf16x8*)(lds + PG8_SA(b, h) + aoff + m * 2048 + k * 1024); } while (0)
#define PG8_LDB(dst, b, h) do { _Pragma("unroll") for (int n = 0; n < 2; ++n) _Pragma("unroll") for (int k = 0; k < 2; ++k) dst[n][k] = *(const PG8_LAS bf16x8*)(lds + PG8_SB(b, h) + boff + n * 2048 + k * 1024); } while (0)
#define PG8_MMA(ai, bj, At, Bt) do { __builtin_amdgcn_s_setprio(1); _Pragma("unroll") for (int m = 0; m < 4; ++m) _Pragma("unroll") for (int n = 0; n < 2; ++n) _Pragma("unroll") for (int k = 0; k < 2; ++k) \
        acc[ai][bj][m][n] = __builtin_amdgcn_mfma_f32_16x16x32_bf16(Bt[n][k], At[m][k], acc[ai][bj][m][n], 0, 0, 0); __builtin_amdgcn_s_setprio(0); } while (0)
#define PG8_WAIT_V(n) asm volatile("s_waitcnt vmcnt(" #n ")" ::: "memory")
#define PG8_WAIT_L(n) asm volatile("s_waitcnt lgkmcnt(" #n ")" ::: "memory")
#define PG8_BAR __builtin_amdgcn_s_barrier()
#define PG8_SCHED __builtin_amdgcn_sched_barrier(0)
    Unit cur, nxt; int ui = 0;
    if (!S.next(0, cur)) return;
    f32x4 acc[2][2][4][2];
#pragma unroll
    for (int a = 0; a < 2; ++a)
#pragma unroll
        for (int b = 0; b < 2; ++b)
#pragma unroll
            for (int m = 0; m < 4; ++m)
#pragma unroll
                for (int n = 0; n < 2; ++n) acc[a][b][m][n] = (f32x4){0.f, 0.f, 0.f, 0.f};
    bf16x8 At[4][2], B0[2][2], B1[2][2];
    const char* cA = (const char*)g.A + (size_t)cur.pm * tstep; const char* cB = (const char*)g.Bt + (size_t)cur.pn * tstep;
    S.a_ready(cur);
    if constexpr (SP2) {
        PG8_STAGE(PG8_SB(0, 0), cB, voffB); PG8_STAGE(PG8_SB(0, 1), cB + hstep, voffB); PG8_STAGE(PG8_SA(0, 0), cA, voffA); PG8_STAGE(PG8_SA(0, 1), cA + hstep, voffA);
        if (wr == 1) PG8_BAR;
        PG8_WAIT_V(2); PG8_BAR;
        PG8_STAGE(PG8_SB(1, 0), cB + kstep, voffB); PG8_STAGE(PG8_SA(1, 0), cA + kstep, voffA); PG8_STAGE(PG8_SB(1, 1), cB + hstep + kstep, voffB);
        PG8_WAIT_V(6); PG8_BAR;
    } else {
        PG8_STAGE(PG8_SB(0, 0), cB, voffB); PG8_STAGE(PG8_SA(0, 0), cA, voffA); PG8_STAGE(PG8_SB(0, 1), cB + hstep, voffB); PG8_STAGE(PG8_SA(0, 1), cA + hstep, voffA);
        if (wr == 1) PG8_BAR;
        PG8_WAIT_V(4); PG8_BAR;
        PG8_STAGE(PG8_SB(1, 0), cB + kstep, voffB); PG8_STAGE(PG8_SA(1, 0), cA + kstep, voffA); PG8_STAGE(PG8_SB(1, 1), cB + hstep + kstep, voffB);
        PG8_WAIT_V(6); PG8_BAR;
    }
    for (;;) {
        const bool has_next = S.next(ui + 1, nxt);
        const char* nA = has_next ? (const char*)g.A + (size_t)nxt.pm * tstep : cA; const char* nB = has_next ? (const char*)g.Bt + (size_t)nxt.pn * tstep : cB;
        for (int t = 0; t < nt; t += 2) {
            const bool last = (t == nt - 2);
            const char* a1 = cA + (size_t)(t + 1) * kstep;
            const char* a2 = last ? nA : cA + (size_t)(t + 2) * kstep; const char* b2 = last ? nB : cB + (size_t)(t + 2) * kstep;
            const char* a3 = a2 + kstep; const char* b3 = b2 + kstep;
            if (last && has_next) S.a_ready(nxt);
            if constexpr (SP2) {
            PG8_LDB(B0, 0, 0); PG8_LDB(B1, 0, 1); PG8_SCHED; PG8_LDA(At, 0, 0); PG8_STAGE(PG8_SA(1, 1), a1 + hstep, voffA);
            PG8_WAIT_V(8); PG8_WAIT_L(0); PG8_BAR; PG8_MMA(0, 0, At, B0); PG8_MMA(0, 1, At, B1); PG8_BAR; PG8_SCHED;
            PG8_LDA(At, 0, 1); PG8_STAGE(PG8_SB(0, 0), b2, voffB); PG8_STAGE(PG8_SB(0, 1), b2 + hstep, voffB); PG8_STAGE(PG8_SA(0, 0), a2, voffA);
            PG8_WAIT_V(8); PG8_WAIT_L(0); PG8_BAR; PG8_MMA(1, 0, At, B0); PG8_MMA(1, 1, At, B1); PG8_BAR; PG8_SCHED;
            PG8_LDB(B0, 1, 0); PG8_LDB(B1, 1, 1); PG8_SCHED; PG8_LDA(At, 1, 0); PG8_STAGE(PG8_SA(0, 1), a2 + hstep, voffA);
            PG8_WAIT_V(8); PG8_WAIT_L(0); PG8_BAR; PG8_MMA(0, 0, At, B0); PG8_MMA(0, 1, At, B1); PG8_BAR; PG8_SCHED;
            PG8_LDA(At, 1, 1); PG8_STAGE(PG8_SB(1, 0), b3, voffB); PG8_STAGE(PG8_SB(1, 1), b3 + hstep, voffB); PG8_STAGE(PG8_SA(1, 0), a3, voffA);
            PG8_WAIT_V(8); PG8_WAIT_L(0); PG8_BAR; PG8_MMA(1, 0, At, B0); PG8_MMA(1, 1, At, B1); PG8_BAR; PG8_SCHED;
            } else {
            PG8_LDB(B0, 0, 0); PG8_SCHED; PG8_LDA(At, 0, 0); PG8_STAGE(PG8_SA(1, 1), a1 + hstep, voffA);
            PG8_WAIT_L(8); PG8_BAR; PG8_WAIT_L(0); PG8_MMA(0, 0, At, B0); PG8_BAR; PG8_SCHED;
            PG8_LDB(B1, 0, 1); PG8_STAGE(PG8_SB(0, 0), b2, voffB);
            PG8_BAR; PG8_WAIT_L(0); PG8_MMA(0, 1, At, B1); PG8_BAR;
            PG8_LDA(At, 0, 1); PG8_STAGE(PG8_SA(0, 0), a2, voffA);
            PG8_BAR; PG8_WAIT_L(0); PG8_MMA(1, 0, At, B0); PG8_BAR; PG8_SCHED;
            PG8_STAGE(PG8_SB(0, 1), b2 + hstep, voffB);
            PG8_WAIT_V(6); PG8_BAR; PG8_MMA(1, 1, At, B1); PG8_BAR;
            PG8_LDB(B0, 1, 0); PG8_SCHED; PG8_LDA(At, 1, 0); PG8_STAGE(PG8_SA(0, 1), a2 + hstep, voffA);
            PG8_WAIT_L(8); PG8_BAR; PG8_WAIT_L(0); PG8_MMA(0, 0, At, B0); PG8_BAR; PG8_SCHED;
            PG8_LDB(B1, 1, 1); PG8_STAGE(PG8_SB(1, 0), b3, voffB);
            PG8_BAR; PG8_WAIT_L(0); PG8_MMA(0, 1, At, B1); PG8_BAR;
            PG8_LDA(At, 1, 1); PG8_STAGE(PG8_SA(1, 0), a3, voffA);
            PG8_BAR; PG8_WAIT_L(0); PG8_MMA(1, 0, At, B0); PG8_BAR; PG8_SCHED;
            PG8_STAGE(PG8_SB(1, 1), b3 + hstep, voffB);
            PG8_WAIT_V(6); PG8_BAR; PG8_MMA(1, 1, At, B1); PG8_BAR;
            }
        }
        if constexpr (ALIGN_EPI) { if (wr == 0) PG8_BAR; }
        if constexpr (!Epi::AFTER_DRAIN) { E(acc, cur, wr, wc, fr, fq); S.done(cur); }
        if (!has_next) break;
#pragma unroll
        for (int a = 0; a < 2; ++a)
#pragma unroll
            for (int b = 0; b < 2; ++b)
#pragma unroll
                for (int m = 0; m < 4; ++m)
#pragma unroll
                    for (int n = 0; n < 2; ++n) acc[a][b][m][n] = (f32x4){0.f, 0.f, 0.f, 0.f};
        cur = nxt; cA = nA; cB = nB; ++ui;
        if constexpr (ALIGN_EPI) { if (wr == 1) PG8_BAR; }
    }
    PG8_WAIT_V(0);
    if constexpr (!ALIGN_EPI) { if (wr == 0) PG8_BAR; }
    PG8_BAR;
    if constexpr (Epi::AFTER_DRAIN) { E.fused(acc, cur, wr, wc, fr, fq, lds, wid, lane); S.done(cur); }
#undef PG8_SA
#undef PG8_SB
#undef PG8_STAGE
#undef PG8_LDA
#undef PG8_LDB
#undef PG8_MMA
#undef PG8_WAIT_V
#undef PG8_WAIT_L
#undef PG8_BAR
#undef PG8_SCHED
}
}

#define LAS __attribute__((address_space(3)))
typedef unsigned short bf16_t;
typedef float f32x4 __attribute__((ext_vector_type(4)));
typedef short bf16x8 __attribute__((ext_vector_type(8)));
typedef unsigned u32x4 __attribute__((ext_vector_type(4)));
typedef unsigned u32x2 __attribute__((ext_vector_type(2)));
typedef float f32x2_t __attribute__((ext_vector_type(2)));
constexpr int T = 16384, DM = 1024, SEQ = 4096, FF = 4096, ZW = 4160, ZS = 16384 * 128;
constexpr size_t MiB = 1u << 20;
constexpr size_t WS_G0 = 2 * MiB;
constexpr size_t WS_FG = WS_G0 + 512 * 1024;
constexpr size_t WS_CUM = WS_FG + 512 * 1024;
constexpr size_t WS_MEMN = 4 * MiB;
constexpr size_t WS_MEMKV = 6 * MiB;
constexpr size_t WS_W = 10 * MiB;
constexpr size_t W_INA = WS_W, W_INC = WS_W + 8 * MiB, W_OUTA = WS_W + 16 * MiB, W_OUTC = WS_W + 18 * MiB, W_KV = WS_W + 20 * MiB,
                 W_Q0 = WS_W + 24 * MiB, W_Q1 = WS_W + 26 * MiB, W_O0 = WS_W + 28 * MiB, W_O1 = WS_W + 30 * MiB, W_1 = WS_W + 32 * MiB, W_2 = WS_W + 40 * MiB;
constexpr size_t WS_Z = 58 * MiB, WS_A1 = 188 * MiB, WS_A2 = 220 * MiB, WS_END = 252 * MiB;
constexpr int LDS_BYTES = 147456;
constexpr float EPS = 1e-6f;
constexpr float LOG2E = 1.4426950408889634f;

__device__ __forceinline__ float bf2f(unsigned short b) { return __uint_as_float((unsigned)b << 16); }
typedef __bf16 bf16x2_hw __attribute__((ext_vector_type(2)));
__device__ __forceinline__ unsigned pk2(float lo, float hi) { const f32x2_t v = {lo, hi}; return __builtin_bit_cast(unsigned, __builtin_convertvector(v, bf16x2_hw)); }
__device__ __forceinline__ unsigned f2bf(float f) { return pk2(f, 0.f) & 0xffffu; }
__device__ __forceinline__ float wave_sum(float v) {
#pragma unroll
    for (int o = 1; o < 64; o <<= 1) v += __shfl_xor(v, o);
    return v;
}
__device__ __forceinline__ float flogf_(float x) { return __builtin_amdgcn_logf(x) * 0.6931471805599453f; }
__device__ __forceinline__ float logsigmoidf_(float x) { return fminf(x, 0.f) - flogf_(1.f + __expf(-fabsf(x))); }
__device__ __forceinline__ float rcpf_(float x) { return __builtin_amdgcn_rcpf(x); }
__device__ __forceinline__ float sigmoidf_(float x) { return rcpf_(1.f + __expf(-x)); }
__device__ __forceinline__ float siluf_(float x) { return x * rcpf_(1.f + __expf(-x)); }

#define LBAR() asm volatile("s_waitcnt lgkmcnt(0)\n\ts_barrier" ::: "memory")
#define MFMA16(a, b, c) __builtin_amdgcn_mfma_f32_16x16x32_bf16((a), (b), (c), 0, 0, 0)
__device__ __forceinline__ bf16x8 ldf(const LAS bf16_t* p) { return *(const LAS bf16x8*)p; }

__device__ __forceinline__ void transpose_item(const float* __restrict__ W, int K, int pitch, int src_col0, bf16_t* __restrict__ WT, int dst_row0, LAS float* scr, int kb, int lane, const float* __restrict__ gk) {
    const int k0 = 64 * kb;
    float r_[32], g_[32];
#pragma unroll
    for (int i = 0; i < 32; ++i) { const int kk = 2 * i + (lane >> 5); r_[i] = W[(size_t)(k0 + kk) * pitch + src_col0 + (lane & 31)]; g_[i] = gk ? gk[k0 + kk] : 1.f; }
#pragma unroll
    for (int i = 0; i < 32; ++i) { const int kk = 2 * i + (lane >> 5); scr[kk * 33 + (lane & 31)] = r_[i] * g_[i]; }
    asm volatile("s_waitcnt lgkmcnt(0)" ::: "memory");
    const int c = lane & 7;
#pragma unroll
    for (int j = 0; j < 4; ++j) { const int n = (lane >> 3) + 8 * j; const LAS float* s = scr + (8 * c) * 33 + n;
        u32x4 o; o.x = pk2(s[0 * 33], s[1 * 33]); o.y = pk2(s[2 * 33], s[3 * 33]); o.z = pk2(s[4 * 33], s[5 * 33]); o.w = pk2(s[6 * 33], s[7 * 33]);
        *(u32x4*)(WT + (size_t)(dst_row0 + n) * K + k0 + 8 * c) = o; }
    asm volatile("s_waitcnt lgkmcnt(0)" ::: "memory");
}
__device__ __forceinline__ void transpose_matrix(const float* W, int K, int pitch, int ncols, int gap_at, int gap, bf16_t* WT, LAS float* scr, int gw, int ngw, int lane, const float* gk = nullptr) {
    const int nblk = ncols / 32, items = (K / 64) * nblk;
    for (int it = gw; it < items; it += ngw) { const int kb = it / nblk, nb = it % nblk; const int n0 = 32 * nb;
        transpose_item(W, K, pitch, n0 + (n0 >= gap_at ? gap : 0), WT, n0, scr, kb, lane, gk); }
}

template <bool OUTF32, int GMODE, bool INBF16 = false, bool NOSTORE = false>
__device__ __forceinline__ void norm_rows(const void* src_, const float* __restrict__ g, void* dst, int rows, int gw, int ngw, int lane,
                                          const LAS float* Wg, const float* __restrict__ gbias, float* __restrict__ gate_out) {
    f32x4 gv[4];
#pragma unroll
    for (int j = 0; j < 4; ++j) gv[j] = *(const f32x4*)(g + 4 * lane + 256 * j);
    f32x4 nf[4]; u32x2 nb[4];
#define NR_LOAD(rr) do { _Pragma("unroll") for (int j = 0; j < 4; ++j) { if (INBF16) nb[j] = *(const u32x2*)((const bf16_t*)src_ + (size_t)(rr) * DM + 4 * lane + 256 * j); \
        else nf[j] = *(const f32x4*)((const float*)src_ + (size_t)(rr) * DM + 4 * lane + 256 * j); } } while (0)
    if (gw < rows) NR_LOAD(gw);
    for (int r = gw; r < rows; r += ngw) {
        f32x4 v[4]; float s = 0.f;
#pragma unroll
        for (int j = 0; j < 4; ++j) {
            if (INBF16) v[j] = (f32x4){__uint_as_float(nb[j].x << 16), __uint_as_float(nb[j].x & 0xffff0000u), __uint_as_float(nb[j].y << 16), __uint_as_float(nb[j].y & 0xffff0000u)};
            else v[j] = nf[j];
            s += (v[j].x * v[j].x + v[j].y * v[j].y) + (v[j].z * v[j].z + v[j].w * v[j].w); }
        if (r + ngw < rows) NR_LOAD(r + ngw);
        const float rstd = rsqrtf(wave_sum(s) * (1.f / DM) + EPS);
#pragma unroll
        for (int j = 0; j < 4; ++j) v[j] = v[j] * rstd * gv[j];
        if (NOSTORE) {} else if (OUTF32) { float* o = (float*)dst + (size_t)r * DM;
#pragma unroll
            for (int j = 0; j < 4; ++j) *(f32x4*)(o + 4 * lane + 256 * j) = v[j];
        } else { bf16_t* o = (bf16_t*)dst + (size_t)r * DM;
#pragma unroll
            for (int j = 0; j < 4; ++j) { u32x2 w; w.x = pk2(v[j].x, v[j].y); w.y = pk2(v[j].z, v[j].w); *(u32x2*)(o + 4 * lane + 256 * j) = w; } }
        if (GMODE != 0) {
            float myv = 0.f;
#pragma unroll
            for (int gi = 0; gi < 8; ++gi) { float d = 0.f;
#pragma unroll
                for (int j = 0; j < 4; ++j) { const f32x4 wv = *(const LAS f32x4*)(Wg + gi * 1024 + 4 * lane + 256 * j); d += (v[j].x * wv.x + v[j].y * wv.y) + (v[j].z * wv.z + v[j].w * wv.w); }
                d = wave_sum(d); if (lane == gi) myv = d; }
            if (lane < 8) { float val = myv + gbias[lane]; if (GMODE == 2) val = logsigmoidf_(val); gate_out[(size_t)r * 8 + lane] = val; }
        }
    }
}
#undef NR_LOAD
__device__ __forceinline__ void stage_gate_w(const float* __restrict__ W, int pitch, int col0, LAS float* Wg) {
    int t0 = threadIdx.x; asm volatile("" : "+v"(t0));
#pragma unroll 4
    for (int it = 0; it < 16; ++it) { const int idx = t0 + 512 * it; const int k = idx >> 3, gi = idx & 7; Wg[gi * 1024 + k] = W[(size_t)k * pitch + col0 + gi]; }
}

constexpr int LDQ = 136, LDP = 72, LDV = 72, LDC = 136, LDO = 132;
constexpr size_t WS_MS = 65536, WS_DCG = 65536 + 4096, WS_VEC = 1u << 20, WS_RS = (size_t)252 << 20;
__device__ __forceinline__ void mlstm_prescan(const float* __restrict__ gates, float* __restrict__ MS, float* __restrict__ DCG, int bh, int lane) {
    const int b = bh >> 2, h = bh & 3; float run = 0.f, pm = -INFINITY;
    const float* gp = gates + ((size_t)b * SEQ + 64 * lane) * 8;
    float ipv[64], fpv[64];
#pragma unroll
    for (int t = 0; t < 64; ++t) { ipv[t] = gp[t * 8 + h]; fpv[t] = gp[t * 8 + 4 + h]; }
#pragma unroll
    for (int t = 0; t < 64; ++t) { run += fminf(fpv[t], 0.f) - flogf_(1.f + __expf(-fabsf(fpv[t]))); pm = fmaxf(pm, ipv[t] - run); }
    float sa = run, sb_ = pm + run;
#pragma unroll
    for (int o = 1; o < 64; o <<= 1) { const float pa = __shfl_up(sa, o), pb = __shfl_up(sb_, o); if (lane >= o) { sb_ = fmaxf(pb + sa, sb_); sa = pa + sa; } }
    const float mnext = fmaxf(sa, sb_);
    float msv = __shfl_up(mnext, 1); if (lane == 0) msv = 0.f;
    const float dcv = __expf(msv - fmaxf(msv, pm));
    MS[bh * 64 + lane] = msv;
    float p = dcv; p *= __shfl_xor(p, 1); p *= __shfl_xor(p, 2); p *= __shfl_xor(p, 4);
    if ((lane & 7) == 0) DCG[bh * 8 + (lane >> 3)] = p;
}
template <bool MLSTM, bool FULL>
__device__ __forceinline__ void scan_group(LAS unsigned char* lds, int b, int h, int g, int unit, const bf16_t* __restrict__ Z, const float* __restrict__ gates,
                                           const float* __restrict__ convw, const float* __restrict__ lbl, const float* __restrict__ ng, bf16_t* __restrict__ Y,
                                           float* __restrict__ LOC, float* __restrict__ VEC, const float* __restrict__ MS, const float* __restrict__ DCG) {
    if (!FULL && g == 7) return;
    int tid = threadIdx.x; asm volatile("" : "+v"(tid)); const int lane = tid & 63, w = __builtin_amdgcn_readfirstlane(tid >> 6), fr = lane & 15, fq = lane >> 4;
    LAS bf16_t* Qs = (LAS bf16_t*)(lds + 0);
    LAS bf16_t* Ks = (LAS bf16_t*)(lds + 17408);
    LAS float* Os = (LAS float*)(lds + 0);
    LAS bf16_t* KhT = (LAS bf16_t*)(lds + 34816);
    LAS bf16_t* VT = (LAS bf16_t*)(lds + 53248);
    LAS bf16_t* Ps = (LAS bf16_t*)(lds + 71680);
    LAS bf16_t* CTb = (LAS bf16_t*)(lds + 80896);
    LAS float* F = (LAS float*)(lds + 115712);
    LAS float* rt = F; LAS float* av = F + 64; LAS float* winter = F + 128; LAS float* emt = F + 192; LAS float* wsv = F + 256; LAS float* den = F + 320;
    LAS float* nvec = F + 384; LAS float* bl = F + 512; LAS float* tot = F + 640; LAS float* misc = F + 1664;
    const unsigned* Zq = (const unsigned*)(Z + (size_t)(MLSTM ? h : 16 + h) * ZS) + lane;
    const unsigned* Zk = (const unsigned*)(Z + (size_t)(MLSTM ? 4 + h : 20 + h) * ZS) + lane;
    const unsigned* Zv = (const unsigned*)(Z + (size_t)(MLSTM ? 8 + h : 24 + h) * ZS) + lane;
    const bf16_t* Zg = Z + (size_t)(MLSTM ? 12 + h : 28 + h) * ZS;
    const int ybase = MLSTM ? (h * 128) : (512 + h * 128);
    float wq[2][4], wk[2][4]; float lb[2] = {0.f, 0.f};
    if (MLSTM) {
#pragma unroll
        for (int cc = 0; cc < 2; ++cc)
#pragma unroll
            for (int j = 0; j < 4; ++j) { wq[cc][j] = convw[j * 1024 + h * 128 + 2 * lane + cc]; wk[cc][j] = convw[j * 1024 + 512 + h * 128 + 2 * lane + cc]; }
    } else {
#pragma unroll
        for (int cc = 0; cc < 2; ++cc) { const float l0 = lbl[h * 128 + 2 * lane + cc], l1 = lbl[512 + h * 128 + 2 * lane + cc]; lb[cc] = 1.f / (1.f + __expf(l1 - l0)); } }
    f32x4 cacc[8];
#pragma unroll
    for (int i = 0; i < 8; ++i) cacc[i] = (f32x4){0.f, 0.f, 0.f, 0.f};
    float nv = 0.f, blsum[2] = {0.f, 0.f};
    if (FULL) {
        f32x4 bufA[8], bufB[8], vecA[8], vecB[8]; float nA = 0.f, nB = 0.f;
#define SG_LOAD(gp_, buf, vec, nn) do { const int up_ = unit - g + (gp_); const float* lp_ = LOC + (size_t)up_ * 16384; \
            _Pragma("unroll") for (int dt = 0; dt < 8; ++dt) { buf[dt] = *(const f32x4*)(lp_ + (size_t)(dt * 512 + tid) * 4); if (!MLSTM) vec[dt] = *(const f32x4*)(VEC + (size_t)up_ * 128 + 16 * dt + 4 * fq); } \
            if (MLSTM) nn = VEC[(size_t)up_ * 128 + (tid & 127)]; } while (0)
#define SG_COMB(gp_, buf, vec, nn) do { float dsc = 1.f; if (MLSTM) dsc = DCG[(b * 4 + h) * 8 + (gp_)]; \
            _Pragma("unroll") for (int dt = 0; dt < 8; ++dt) { f32x4 sc; if (MLSTM) sc = (f32x4){dsc, dsc, dsc, dsc}; else sc = (f32x4){__expf(vec[dt][0]), __expf(vec[dt][1]), __expf(vec[dt][2]), __expf(vec[dt][3])}; \
                cacc[dt] = cacc[dt] * sc + buf[dt]; } \
            if (MLSTM) nv = dsc * nv + nn; } while (0)
        if (g > 0) SG_LOAD(0, bufA, vecA, nA);
#pragma unroll 1
        for (int gp = 0; gp < g; gp += 2) {
            if (gp + 1 < g) SG_LOAD(gp + 1, bufB, vecB, nB);
            SG_COMB(gp, bufA, vecA, nA);
            if (gp + 1 < g) { if (gp + 2 < g) SG_LOAD(gp + 2, bufA, vecA, nA); SG_COMB(gp + 1, bufB, vecB, nB); }
        }
#undef SG_LOAD
#undef SG_COMB
#pragma unroll
        for (int dt = 0; dt < 8; ++dt) { u32x2 pkd; pkd.x = pk2(cacc[dt][0], cacc[dt][1]); pkd.y = pk2(cacc[dt][2], cacc[dt][3]);
            *(LAS u32x2*)(CTb + (16 * w + fr) * LDC + 16 * dt + 4 * fq) = pkd; }
    }
    if (tid < 128) nvec[tid] = nv;
    float m_carry = MLSTM ? MS[(b * 4 + h) * 64 + 8 * g] : 0.f;
    unsigned rk[11], rq[11], rq8[8], rv[8]; u32x4 gE0 = (u32x4){0u, 0u, 0u, 0u}, gE1 = gE0; float gi = 0.f, gf = 0.f;
#define SCAN_LOAD(cc) do { const long rb_ = (long)b * SEQ + (cc) * 64; \
        if (MLSTM) { _Pragma("unroll") for (int i = 0; i < 11; ++i) { const int r = 8 * w - 3 + i; const int pos = (cc) * 64 + r; \
                rk[i] = Zk[(rb_ + (pos >= 0 ? r : 0)) * 64]; if (FULL) rq[i] = Zq[(rb_ + (pos >= 0 ? r : 0)) * 64]; } \
            _Pragma("unroll") for (int i = 0; i < 8; ++i) rv[i] = Zv[(rb_ + 8 * w + i) * 64]; \
            if (w == 0) { gi = gates[(rb_ + lane) * 8 + h]; gf = gates[(rb_ + lane) * 8 + 4 + h]; } \
        } else { _Pragma("unroll") for (int i = 0; i < 8; ++i) { rk[i] = Zk[(rb_ + 8 * w + i) * 64]; if (FULL) rq8[i] = Zq[(rb_ + 8 * w + i) * 64]; rv[i] = Zv[(rb_ + 8 * w + i) * 64]; } } \
        } while (0)
    SCAN_LOAD(8 * g);
    __syncthreads();
#pragma unroll 1
    for (int c = 8 * g; c < 8 * g + 8; ++c) {
        const long rowbase = (long)b * SEQ + c * 64;
        float kreg[2][8];
        if (MLSTM) {
            if (c == 0 && w == 0) { rk[0] = 0u; rk[1] = 0u; rk[2] = 0u; if (FULL) { rq[0] = 0u; rq[1] = 0u; rq[2] = 0u; } }
#pragma unroll
            for (int i = 0; i < 8; ++i) { const int row = 8 * w + i;
                const float y0 = wk[0][0] * bf2f(rk[i] & 0xffffu) + wk[0][1] * bf2f(rk[i + 1] & 0xffffu) + wk[0][2] * bf2f(rk[i + 2] & 0xffffu) + wk[0][3] * bf2f(rk[i + 3] & 0xffffu);
                const float y1 = wk[1][0] * bf2f(rk[i] >> 16) + wk[1][1] * bf2f(rk[i + 1] >> 16) + wk[1][2] * bf2f(rk[i + 2] >> 16) + wk[1][3] * bf2f(rk[i + 3] >> 16);
                kreg[0][i] = siluf_(y0) * 0.08838834764831845f; kreg[1][i] = siluf_(y1) * 0.08838834764831845f;
                if (FULL) *(LAS unsigned*)(Ks + row * LDQ + 2 * lane) = pk2(kreg[0][i], kreg[1][i]); }
            { u32x4 lo, hi;
              lo.x = (rv[0] & 0xffffu) | (rv[1] << 16); lo.y = (rv[2] & 0xffffu) | (rv[3] << 16); lo.z = (rv[4] & 0xffffu) | (rv[5] << 16); lo.w = (rv[6] & 0xffffu) | (rv[7] << 16);
              hi.x = (rv[0] >> 16) | (rv[1] & 0xffff0000u); hi.y = (rv[2] >> 16) | (rv[3] & 0xffff0000u); hi.z = (rv[4] >> 16) | (rv[5] & 0xffff0000u); hi.w = (rv[6] >> 16) | (rv[7] & 0xffff0000u);
              *(LAS u32x4*)(VT + (2 * lane) * LDV + 8 * w) = lo; *(LAS u32x4*)(VT + (2 * lane + 1) * LDV + 8 * w) = hi; }
            if (FULL) {
#pragma unroll
                for (int i = 0; i < 8; ++i) {
                    const float y0 = wq[0][0] * bf2f(rq[i] & 0xffffu) + wq[0][1] * bf2f(rq[i + 1] & 0xffffu) + wq[0][2] * bf2f(rq[i + 2] & 0xffffu) + wq[0][3] * bf2f(rq[i + 3] & 0xffffu);
                    const float y1 = wq[1][0] * bf2f(rq[i] >> 16) + wq[1][1] * bf2f(rq[i + 1] >> 16) + wq[1][2] * bf2f(rq[i + 2] >> 16) + wq[1][3] * bf2f(rq[i + 3] >> 16);
                    *(LAS unsigned*)(Qs + (8 * w + i) * LDQ + 2 * lane) = pk2(siluf_(y0), siluf_(y1)); } }
            if (w == 0) {
                float bc = fminf(gf, 0.f) - flogf_(1.f + __expf(-fabsf(gf)));
#pragma unroll
                for (int o = 1; o < 64; o <<= 1) { const float t_ = __shfl_up(bc, o); if (lane >= o) bc += t_; }
                const float a_ = gi - bc; float pm = a_;
#pragma unroll
                for (int o = 1; o < 64; o <<= 1) { const float t_ = __shfl_up(pm, o); if (lane >= o) pm = fmaxf(pm, t_); }
                const float mx = fmaxf(m_carry, pm);
                rt[lane] = -mx; av[lane] = a_; winter[lane] = __expf(m_carry - mx); emt[lane] = __expf(-(bc + mx));
                const float pm63 = __shfl(pm, 63), bl63 = __shfl(bc, 63);
                const float mx63 = fmaxf(m_carry, pm63);
                wsv[lane] = __expf(a_ - mx63);
                if (lane == 0) misc[0] = __expf(m_carry - mx63);
                m_carry = bl63 + mx63;
            }
        } else {
            float lc[2][8], qs[2][8], vs[2][8]; float run[2] = {0.f, 0.f};
#pragma unroll
            for (int i = 0; i < 8; ++i)
#pragma unroll
                for (int cc = 0; cc < 2; ++cc) {
                    const float zf = bf2f(cc ? (rk[i] >> 16) : (rk[i] & 0xffffu));
                    const float sg = rcpf_(1.f + __expf(-zf)), sgn = rcpf_(1.f + __expf(zf));
                    const float f = lb[cc] + (1.f - lb[cc]) * sg; run[cc] += flogf_(f); lc[cc][i] = run[cc]; kreg[cc][i] = (1.f - lb[cc]) * sgn;
                    if (FULL) qs[cc][i] = siluf_(bf2f(cc ? (rq8[i] >> 16) : (rq8[i] & 0xffffu)));
                    vs[cc][i] = siluf_(bf2f(cc ? (rv[i] >> 16) : (rv[i] & 0xffffu))); }
#pragma unroll
            for (int cc = 0; cc < 2; ++cc) { u32x4 vv; vv.x = pk2(vs[cc][0], vs[cc][1]); vv.y = pk2(vs[cc][2], vs[cc][3]); vv.z = pk2(vs[cc][4], vs[cc][5]); vv.w = pk2(vs[cc][6], vs[cc][7]);
                *(LAS u32x4*)(VT + (2 * lane + cc) * LDV + 8 * w) = vv; }
            *(LAS f32x2_t*)(tot + w * 128 + 2 * lane) = (f32x2_t){run[0], run[1]};
            LBAR();
            float prefix[2] = {0.f, 0.f}, total[2] = {0.f, 0.f};
#pragma unroll
            for (int p_ = 0; p_ < 8; ++p_) { const f32x2_t tv = *(const LAS f32x2_t*)(tot + p_ * 128 + 2 * lane); total[0] += tv.x; total[1] += tv.y; if (p_ < w) { prefix[0] += tv.x; prefix[1] += tv.y; } }
            blsum[0] += total[0]; blsum[1] += total[1];
            float kh[2][8];
#pragma unroll
            for (int i = 0; i < 8; ++i) { const int row = 8 * w + i; const float b0 = prefix[0] + lc[0][i], b1 = prefix[1] + lc[1][i];
                if (FULL) { *(LAS unsigned*)(Qs + row * LDQ + 2 * lane) = pk2(qs[0][i] * __expf(b0), qs[1][i] * __expf(b1));
                            *(LAS unsigned*)(Ks + row * LDQ + 2 * lane) = pk2(kreg[0][i] * __expf(-b0), kreg[1][i] * __expf(-b1)); }
                kh[0][i] = kreg[0][i] * __expf(total[0] - b0); kh[1][i] = kreg[1][i] * __expf(total[1] - b1); }
#pragma unroll
            for (int cc = 0; cc < 2; ++cc) { u32x4 kk4; kk4.x = pk2(kh[cc][0], kh[cc][1]); kk4.y = pk2(kh[cc][2], kh[cc][3]); kk4.z = pk2(kh[cc][4], kh[cc][5]); kk4.w = pk2(kh[cc][6], kh[cc][7]);
                *(LAS u32x4*)(KhT + (2 * lane + cc) * LDV + 8 * w) = kk4; }
            if (w == 0) *(LAS f32x2_t*)(bl + 2 * lane) = (f32x2_t){__expf(total[0]), __expf(total[1])};
        }
        if (c + 1 < 8 * g + 8) SCAN_LOAD(c + 1);
        LBAR();
        if (FULL) { const bf16_t* gp_ = Zg + (rowbase + (tid >> 3)) * 128 + 16 * (tid & 7); gE0 = *(const u32x4*)gp_; gE1 = *(const u32x4*)(gp_ + 8); }
        if (MLSTM) { const f32x4 w0 = *(const LAS f32x4*)(wsv + 8 * w), w1 = *(const LAS f32x4*)(wsv + 8 * w + 4);
#pragma unroll
            for (int cc = 0; cc < 2; ++cc) { u32x4 kk4; kk4.x = pk2(kreg[cc][0] * w0[0], kreg[cc][1] * w0[1]); kk4.y = pk2(kreg[cc][2] * w0[2], kreg[cc][3] * w0[3]);
                kk4.z = pk2(kreg[cc][4] * w1[0], kreg[cc][5] * w1[1]); kk4.w = pk2(kreg[cc][6] * w1[2], kreg[cc][7] * w1[3]);
                *(LAS u32x4*)(KhT + (2 * lane + cc) * LDV + 8 * w) = kk4; } }
        if (FULL) { const int tt = w >> 1, st0 = 2 * (w & 1);
            f32x4 s_[2] = {(f32x4){0.f, 0.f, 0.f, 0.f}, (f32x4){0.f, 0.f, 0.f, 0.f}};
#pragma unroll
            for (int kk = 0; kk < 4; ++kk) { const bf16x8 a = ldf(Qs + (16 * tt + fr) * LDQ + 32 * kk + 8 * fq);
#pragma unroll
                for (int i = 0; i < 2; ++i) { const bf16x8 bb = ldf(Ks + (16 * (st0 + i) + fr) * LDQ + 32 * kk + 8 * fq); s_[i] = MFMA16(a, bb, s_[i]); } }
#pragma unroll
            for (int i = 0; i < 2; ++i) { const int si = 16 * (st0 + i) + fr;
#pragma unroll
                for (int j = 0; j < 4; ++j) { const int t_ = 16 * tt + 4 * fq + j; float pv = 0.f;
                    if (si <= t_) pv = MLSTM ? s_[i][j] * __expf(rt[t_] + av[si]) : s_[i][j];
                    Ps[t_ * LDP + si] = (bf16_t)f2bf(pv); } } }
        if (FULL || MLSTM) LBAR();
        if (FULL && MLSTM) { const int t_ = tid >> 3, sub = tid & 7; float s8 = 0.f, qn = 0.f;
#pragma unroll
            for (int i = 0; i < 8; ++i) s8 += bf2f(Ps[t_ * LDP + 8 * sub + i]);
#pragma unroll
            for (int i = 0; i < 16; ++i) qn += bf2f(Qs[t_ * LDQ + 16 * sub + i]) * nvec[16 * sub + i];
            float val = s8 + winter[t_] * qn; val += __shfl_xor(val, 1); val += __shfl_xor(val, 2); val += __shfl_xor(val, 4);
            if (sub == 0) den[t_] = val; }
        f32x4 oacc[4];
        { bf16x8 vb[2]; vb[0] = ldf(VT + (16 * w + fr) * LDV + 8 * fq); vb[1] = ldf(VT + (16 * w + fr) * LDV + 32 + 8 * fq);
            if (FULL) { bf16x8 cb[4];
#pragma unroll
                for (int kk = 0; kk < 4; ++kk) cb[kk] = ldf(CTb + (16 * w + fr) * LDC + 32 * kk + 8 * fq);
#pragma unroll
                for (int tt = 0; tt < 4; ++tt) { f32x4 a1 = (f32x4){0.f, 0.f, 0.f, 0.f}, a2 = (f32x4){0.f, 0.f, 0.f, 0.f};
#pragma unroll
                    for (int kk = 0; kk < 2; ++kk) a1 = MFMA16(ldf(Ps + (16 * tt + fr) * LDP + 32 * kk + 8 * fq), vb[kk], a1);
#pragma unroll
                    for (int kk = 0; kk < 4; ++kk) a2 = MFMA16(ldf(Qs + (16 * tt + fr) * LDQ + 32 * kk + 8 * fq), cb[kk], a2);
                    if (MLSTM) { const f32x4 wi = *(const LAS f32x4*)(winter + 16 * tt + 4 * fq); oacc[tt] = a1 + wi * a2; } else oacc[tt] = a1 + a2;
                    __builtin_amdgcn_sched_barrier(0); } }
            const float dec = MLSTM ? misc[0] : 0.f;
            { bf16x8 kfr[2][2];
#pragma unroll
              for (int kk = 0; kk < 2; ++kk) kfr[0][kk] = ldf(KhT + fr * LDV + 32 * kk + 8 * fq);
#pragma unroll
              for (int dt = 0; dt < 8; ++dt) {
                if (dt < 7) {
#pragma unroll
                    for (int kk = 0; kk < 2; ++kk) kfr[(dt + 1) & 1][kk] = ldf(KhT + (16 * (dt + 1) + fr) * LDV + 32 * kk + 8 * fq); }
                f32x4 sc; if (MLSTM) sc = (f32x4){dec, dec, dec, dec}; else sc = *(const LAS f32x4*)(bl + 16 * dt + 4 * fq);
                __builtin_amdgcn_sched_barrier(0);
                f32x4 a = cacc[dt] * sc;
#pragma unroll
                for (int kk = 0; kk < 2; ++kk) a = MFMA16(kfr[dt & 1][kk], vb[kk], a);
                cacc[dt] = a; __builtin_amdgcn_sched_barrier(0); } } }
        if (FULL) LBAR();
        if (FULL) {
#pragma unroll
            for (int tt = 0; tt < 4; ++tt)
#pragma unroll
                for (int j = 0; j < 4; ++j) Os[(16 * tt + 4 * fq + j) * LDO + 16 * w + fr] = oacc[tt][j];
#pragma unroll
            for (int dt = 0; dt < 8; ++dt) { u32x2 pkd; pkd.x = pk2(cacc[dt][0], cacc[dt][1]); pkd.y = pk2(cacc[dt][2], cacc[dt][3]);
                *(LAS u32x2*)(CTb + (16 * w + fr) * LDC + 16 * dt + 4 * fq) = pkd; } }
        if (MLSTM && tid < 128) { float sm = 0.f;
#pragma unroll
            for (int i = 0; i < 8; ++i) { const u32x4 kk4 = *(const LAS u32x4*)(KhT + tid * LDV + 8 * i);
                sm += (bf2f((unsigned short)(kk4.x & 0xffffu)) + bf2f((unsigned short)(kk4.x >> 16))) + (bf2f((unsigned short)(kk4.y & 0xffffu)) + bf2f((unsigned short)(kk4.y >> 16)))
                    + (bf2f((unsigned short)(kk4.z & 0xffffu)) + bf2f((unsigned short)(kk4.z >> 16))) + (bf2f((unsigned short)(kk4.w & 0xffffu)) + bf2f((unsigned short)(kk4.w >> 16))); }
            nvec[tid] = misc[0] * nvec[tid] + sm; }
        LBAR();
        if (FULL) { const int t_ = tid >> 3, sub = tid & 7;
            const unsigned gw_[8] = {gE0.x, gE0.y, gE0.z, gE0.w, gE1.x, gE1.y, gE1.z, gE1.w};
            float o[16]; float inv = 1.f;
            if (MLSTM) inv = rcpf_(fmaxf(fabsf(den[t_]), emt[t_]));
            float ss = 0.f;
#pragma unroll
            for (int i = 0; i < 16; ++i) { const float gv_ = bf2f((unsigned short)((i & 1) ? (gw_[i >> 1] >> 16) : (gw_[i >> 1] & 0xffffu)));
                float x = Os[t_ * LDO + 16 * sub + i];
                if (MLSTM) x = x * inv * sigmoidf_(gv_);
                o[i] = x; ss += x * x;
                if (!MLSTM) o[i] = x * siluf_(gv_); }
            ss += __shfl_xor(ss, 1); ss += __shfl_xor(ss, 2); ss += __shfl_xor(ss, 4);
            const float rstd = rsqrtf(ss * (1.f / 128.f) + EPS);
            unsigned op[8];
#pragma unroll
            for (int i = 0; i < 8; ++i) op[i] = pk2(o[2 * i] * rstd * ng[h * 128 + 16 * sub + 2 * i], o[2 * i + 1] * rstd * ng[h * 128 + 16 * sub + 2 * i + 1]);
            bf16_t* yp = Y + (rowbase + t_) * DM + ybase + 16 * sub;
            *(u32x4*)yp = (u32x4){op[0], op[1], op[2], op[3]}; *(u32x4*)(yp + 8) = (u32x4){op[4], op[5], op[6], op[7]};
            LBAR();
        }
    }
#undef SCAN_LOAD
    if (!FULL) {
        float* lp = LOC + (size_t)unit * 16384;
#pragma unroll
        for (int dt = 0; dt < 8; ++dt) *(f32x4*)(lp + (size_t)(dt * 512 + tid) * 4) = cacc[dt];
        if (MLSTM) { if (tid < 128) VEC[(size_t)unit * 128 + tid] = nvec[tid]; }
        else if (w == 0) { VEC[(size_t)unit * 128 + 2 * lane] = blsum[0]; VEC[(size_t)unit * 128 + 2 * lane + 1] = blsum[1]; }
    }
}

__device__ __forceinline__ int pcol(int key) { return 32 * (key >> 5) + 8 * ((key >> 2) & 3) + 4 * ((key >> 4) & 1) + (key & 3); }
__device__ __forceinline__ float ex2(float x) { return __builtin_amdgcn_exp2f(x); }

__device__ __forceinline__ int pcol256(int key) { return (key & ~63) | pcol(key & 63); }
__device__ __forceinline__ void xattn_vt_prep(const bf16_t* __restrict__ KV, bf16_t* __restrict__ Vt, int gid) {
    const int e8 = gid & 31, hx = (gid >> 5) & 3, key = (gid >> 7) & 255, b = gid >> 15;
    const u32x4 vv = *(const u32x4*)(KV + (size_t)(b * 256 + key) * 2048 + 1024 + hx * 256 + 8 * e8); const unsigned vw[4] = {vv.x, vv.y, vv.z, vv.w};
    bf16_t* dst = Vt + ((size_t)(b * 4 + hx) * 256 + 8 * e8) * 256 + pcol256(key);
#pragma unroll
    for (int e = 0; e < 8; ++e) dst[e * 256] = (bf16_t)((e & 1) ? (vw[e >> 1] >> 16) : (vw[e >> 1] & 0xffffu));
}
__device__ __forceinline__ void xattn_phase(LAS unsigned char* lds, const bf16_t* __restrict__ Q, const bf16_t* __restrict__ KV, const bf16_t* __restrict__ Vt, bf16_t* __restrict__ O, int rb0, int hx) {
    constexpr int KBUF = 32768, XBUF = 65536;
    int tid = threadIdx.x; asm volatile("" : "+v"(tid)); const int lane = tid & 63, w = __builtin_amdgcn_readfirstlane(tid >> 6), fr = lane & 15, fq = lane >> 4;
    const int ka0 = (fr >> 1) * 1024 + (fr & 1) * 512 + ((fq ^ (fr & 3)) << 4), kx = fr >> 2;
    const int va0 = KBUF + fr * 128;
#pragma unroll 1
    for (int rb = rb0; rb < rb0 + 2; ++rb) {
        const int row0 = rb * 128 + 16 * w; const int b = (rb * 128) / SEQ;
#define XA_DMA(kt_, buf_) do { \
            _Pragma("unroll") for (int i = 0; i < 4; ++i) { const int j = 4 * w + i; const int row = 2 * j + (lane >> 5); const int c = (lane & 31) ^ (row & 15); \
                __builtin_amdgcn_global_load_lds((const unsigned*)(KV + (size_t)(b * 256 + 64 * (kt_) + row) * 2048 + hx * 256 + 8 * c), (LAS unsigned*)(lds + (buf_) * XBUF + j * 1024), 16, 0, 0); } \
            _Pragma("unroll") for (int i = 0; i < 4; ++i) { const int j = 4 * w + i; const int row = 8 * j + (lane >> 3); const int c = (lane & 7) ^ ((row >> 1) & 7); \
                __builtin_amdgcn_global_load_lds((const unsigned*)(Vt + ((size_t)(b * 4 + hx) * 256 + row) * 256 + 64 * (kt_) + 8 * c), (LAS unsigned*)(lds + (buf_) * XBUF + KBUF + j * 1024), 16, 0, 0); } } while (0)
        XA_DMA(0, 0);
        bf16x8 qf[8];
#pragma unroll
        for (int kk = 0; kk < 8; ++kk) qf[kk] = *(const bf16x8*)(Q + (size_t)(row0 + fr) * DM + hx * 256 + 32 * kk + 8 * fq);
        f32x4 ot[16];
#pragma unroll
        for (int i = 0; i < 16; ++i) ot[i] = (f32x4){0.f, 0.f, 0.f, 0.f};
        float mrun = -INFINITY, lrun = 0.f;
        asm volatile("s_waitcnt vmcnt(0)" ::: "memory");
        LBAR();
        for (int kt = 0; kt < 4; ++kt) {
            if (kt + 1 < 4) XA_DMA(kt + 1, (kt + 1) & 1);
            const LAS unsigned char* Kb = lds + (kt & 1) * XBUF;
            f32x4 st[4];
            { bf16x8 kfr[2][4];
#pragma unroll
              for (int kk = 0; kk < 4; ++kk) kfr[0][kk] = *(const LAS bf16x8*)(Kb + ka0 + ((kk ^ kx) << 6));
#pragma unroll
              for (int hb = 0; hb < 8; ++hb) { const int k16 = hb >> 1, k0 = 4 * (hb & 1);
                if (hb < 7) { const int n16 = (hb + 1) >> 1, n0 = 4 * ((hb + 1) & 1);
#pragma unroll
                    for (int kk = 0; kk < 4; ++kk) kfr[(hb + 1) & 1][kk] = *(const LAS bf16x8*)(Kb + n16 * 8192 + ka0 + (((n0 + kk) ^ kx) << 6)); }
                __builtin_amdgcn_sched_barrier(0);
                f32x4 a = (hb & 1) ? st[k16] : (f32x4){0.f, 0.f, 0.f, 0.f};
#pragma unroll
                for (int kk = 0; kk < 4; ++kk) a = MFMA16(kfr[hb & 1][kk], qf[k0 + kk], a);
                st[k16] = a; __builtin_amdgcn_sched_barrier(0); } }
            float mx = -INFINITY;
#pragma unroll
            for (int k16 = 0; k16 < 4; ++k16)
#pragma unroll
                for (int j = 0; j < 4; ++j) mx = fmaxf(mx, st[k16][j]);
            mx = fmaxf(mx, __shfl_xor(mx, 16)); mx = fmaxf(mx, __shfl_xor(mx, 32));
            const float mnew = fmaxf(mrun, mx), alpha = ex2(mrun - mnew); mrun = mnew;
            float ps = 0.f;
#pragma unroll
            for (int k16 = 0; k16 < 4; ++k16)
#pragma unroll
                for (int j = 0; j < 4; ++j) { const float p = ex2(st[k16][j] - mnew); st[k16][j] = p; ps += p; }
            lrun = lrun * alpha + ps;
            bf16x8 pf[2];
#pragma unroll
            for (int kb = 0; kb < 2; ++kb) { u32x4 pw; pw.x = pk2(st[2 * kb][0], st[2 * kb][1]); pw.y = pk2(st[2 * kb][2], st[2 * kb][3]); pw.z = pk2(st[2 * kb + 1][0], st[2 * kb + 1][1]); pw.w = pk2(st[2 * kb + 1][2], st[2 * kb + 1][3]);
                pf[kb] = __builtin_bit_cast(bf16x8, pw); }
            { bf16x8 vfr[2][2];
#pragma unroll
              for (int kb = 0; kb < 2; ++kb) vfr[0][kb] = *(const LAS bf16x8*)(Kb + va0 + (((4 * kb + fq) ^ (fr >> 1)) << 4));
#pragma unroll
              for (int et = 0; et < 16; ++et) {
                if (et < 15) {
#pragma unroll
                    for (int kb = 0; kb < 2; ++kb) vfr[(et + 1) & 1][kb] = *(const LAS bf16x8*)(Kb + (et + 1) * 2048 + va0 + (((4 * kb + fq) ^ (fr >> 1)) << 4)); }
                __builtin_amdgcn_sched_barrier(0);
                f32x4 a = ot[et] * alpha;
#pragma unroll
                for (int kb = 0; kb < 2; ++kb) a = MFMA16(vfr[et & 1][kb], pf[kb], a);
                ot[et] = a; __builtin_amdgcn_sched_barrier(0); } }
            asm volatile("s_waitcnt vmcnt(0)" ::: "memory");
            LBAR();
        }
#undef XA_DMA
        lrun += __shfl_xor(lrun, 16); lrun += __shfl_xor(lrun, 32);
        const float inv = 1.f / lrun;
        bf16_t* op = O + (size_t)(row0 + fr) * DM + hx * 256 + 4 * fq;
#pragma unroll
        for (int et = 0; et < 16; ++et) { u32x2 wv; wv.x = pk2(ot[et][0] * inv, ot[et][1] * inv); wv.y = pk2(ot[et][2] * inv, ot[et][3] * inv); *(u32x2*)(op + 16 * et) = wv; }
    }
}

__device__ __forceinline__ void fox_prep(bf16_t* Z, const float* __restrict__ gq, const float* __restrict__ gk, int gw, int ngw, int lane) {
    const int e0 = 8 * (lane & 15);
    for (int task = gw; task < 16 * (T / 4); task += ngw) { const int slot = task / (T / 4), row = 4 * (task % (T / 4)) + (lane >> 4);
        bf16_t* p = Z + (size_t)slot * ZS + (size_t)row * 128 + e0;
        const u32x4 raw = *(const u32x4*)p; const unsigned rw[4] = {raw.x, raw.y, raw.z, raw.w};
        float x[8]; float ss = 0.f;
#pragma unroll
        for (int i = 0; i < 8; ++i) { x[i] = bf2f((unsigned short)((i & 1) ? (rw[i >> 1] >> 16) : (rw[i >> 1] & 0xffffu))); ss += x[i] * x[i]; }
        ss += __shfl_xor(ss, 1); ss += __shfl_xor(ss, 2); ss += __shfl_xor(ss, 4); ss += __shfl_xor(ss, 8);
        float sc = rsqrtf(ss * (1.f / 128.f) + EPS); const float* g = (slot < 8) ? gq : gk; if (slot < 8) sc *= 0.08838834764831845f * LOG2E;
        u32x4 o; o.x = pk2(x[0] * sc * g[e0], x[1] * sc * g[e0 + 1]); o.y = pk2(x[2] * sc * g[e0 + 2], x[3] * sc * g[e0 + 3]);
        o.z = pk2(x[4] * sc * g[e0 + 4], x[5] * sc * g[e0 + 5]); o.w = pk2(x[6] * sc * g[e0 + 6], x[7] * sc * g[e0 + 7]);
        *(u32x4*)p = o; }
}
__device__ __forceinline__ void fox_cumsum(const float* __restrict__ FG, float* __restrict__ CUM, int bh, int lane) {
    const int b = bh >> 3, h = bh & 7; float v[64]; float run = 0.f;
    const float* p = FG + ((size_t)b * SEQ + 64 * lane) * 8 + h;
#pragma unroll
    for (int i = 0; i < 64; ++i) v[i] = p[i * 8];
#pragma unroll
    for (int i = 0; i < 64; ++i) { run += v[i]; v[i] = run; }
    float inc = run;
#pragma unroll
    for (int o = 1; o < 64; o <<= 1) { const float t_ = __shfl_up(inc, o); if (lane >= o) inc += t_; }
    const float base = inc - run; float* q = CUM + (size_t)bh * SEQ + 64 * lane;
#pragma unroll
    for (int i = 0; i < 16; ++i) *(f32x4*)(q + 4 * i) = (f32x4){base + v[4 * i], base + v[4 * i + 1], base + v[4 * i + 2], base + v[4 * i + 3]};
}

__device__ __forceinline__ void fox_cumsum_lds(LAS unsigned char* lds, const float* __restrict__ FG, int b, int h) {
    int tid = threadIdx.x; asm volatile("" : "+v"(tid)); const int lane = tid & 63, w = __builtin_amdgcn_readfirstlane(tid >> 6);
    LAS float* cumL = (LAS float*)(lds + 66560); LAS float* wtot = (LAS float*)(lds + 66560 + 16384);
    float v[8]; const float* p = FG + ((size_t)b * SEQ + 512 * w + 8 * lane) * 8 + h;
#pragma unroll
    for (int i = 0; i < 8; ++i) v[i] = p[i * 8];
    float run = 0.f;
#pragma unroll
    for (int i = 0; i < 8; ++i) { run += v[i]; v[i] = run; }
    float inc = run;
#pragma unroll
    for (int o = 1; o < 64; o <<= 1) { const float t_ = __shfl_up(inc, o); if (lane >= o) inc += t_; }
    if (lane == 63) wtot[w] = inc;
    LBAR();
    float base = inc - run;
    for (int w2 = 0; w2 < w; ++w2) base += wtot[w2];
#pragma unroll
    for (int i = 0; i < 8; ++i) cumL[512 * w + 8 * lane + i] = base + v[i];
    LBAR();
}
__device__ __forceinline__ void fox_unit(LAS unsigned char* lds, int b, int h, int qb, const bf16_t* __restrict__ Z, const bf16_t* __restrict__ VTg, bf16_t* __restrict__ O) {
    int tid = threadIdx.x; asm volatile("" : "+v"(tid)); const int lane = tid & 63, w = __builtin_amdgcn_readfirstlane(tid >> 6), fr = lane & 15, fq = lane >> 4;
    const LAS float* cum = (const LAS float*)(lds + 66560);
    const int q0 = qb * 256; const long rowb = (long)b * SEQ;
    const float cref = cum[q0];
    bf16x8 qf[2][4]; float cqs[2]; int qpos[2];
#pragma unroll
    for (int qt = 0; qt < 2; ++qt) { qpos[qt] = q0 + 32 * w + 16 * qt + fr; cqs[qt] = (cum[qpos[qt]] - cref) * LOG2E;
#pragma unroll
        for (int kk = 0; kk < 4; ++kk) qf[qt][kk] = *(const bf16x8*)(Z + (size_t)h * ZS + (size_t)(rowb + qpos[qt]) * 128 + 32 * kk + 8 * fq); }
    f32x4 ot[2][8];
#pragma unroll
    for (int qt = 0; qt < 2; ++qt)
#pragma unroll
        for (int i = 0; i < 8; ++i) ot[qt][i] = (f32x4){0.f, 0.f, 0.f, 0.f};
    float mrun[2] = {0.f, 0.f}, lrun[2] = {0.f, 0.f};
    const int ntile = 4 * qb + 4; const int wmax = q0 + 32 * w + 31;
    constexpr int KB_ = 16384, BUFB = 32768 + 256;
    const bf16_t* Kg = Z + (size_t)(8 + h) * ZS + (size_t)rowb * 128;
    const bf16_t* Vg = VTg + (size_t)(b * 8 + h) * 128 * SEQ;
    float cr = 0.f;
#define FOX_DMA(kt_, buf_) do { \
        _Pragma("unroll") for (int i = 0; i < 2; ++i) { const int j = 2 * w + i; const int row = 4 * j + (lane >> 4); const int c = (lane & 15) ^ (row & 15); \
            __builtin_amdgcn_global_load_lds((const unsigned*)(Kg + (size_t)(64 * (kt_) + row) * 128 + 8 * c), (LAS unsigned*)(lds + (buf_) * BUFB + j * 1024), 16, 0, 0); } \
        _Pragma("unroll") for (int i = 0; i < 2; ++i) { const int j = 2 * w + i; const int row = 8 * j + (lane >> 3); const int c = (lane & 7) ^ ((row >> 1) & 7); \
            __builtin_amdgcn_global_load_lds((const unsigned*)(Vg + (size_t)row * SEQ + 64 * (kt_) + 8 * c), (LAS unsigned*)(lds + (buf_) * BUFB + KB_ + j * 1024), 16, 0, 0); } \
        cr = cum[64 * (kt_) + lane]; } while (0)
#define FOX_CKS(buf_) do { if (tid < 64) ((LAS float*)(lds + (buf_) * BUFB + 32768))[tid] = (cr - cref) * LOG2E; } while (0)
    const int ka0 = fr * 256, va0 = KB_ + fr * 128;
    FOX_DMA(0, 0); FOX_CKS(0);
    asm volatile("s_waitcnt vmcnt(0)" ::: "memory");
    LBAR();
    for (int kt = 0; kt < ntile; ++kt) {
        const LAS unsigned char* Kb = lds + (kt & 1) * BUFB; const LAS float* cks = (const LAS float*)(Kb + 32768);
        if (kt + 1 < ntile) FOX_DMA(kt + 1, (kt + 1) & 1);
        if (64 * kt <= wmax) {
            const bool band = (64 * kt + 63 > q0 + 32 * w);
            f32x4 st[2][4]; const float cm0 = cqs[0] - mrun[0], cm1 = cqs[1] - mrun[1];
            bf16x8 kfr[2][4]; f32x4 ckr[2];
#pragma unroll
            for (int kk = 0; kk < 4; ++kk) kfr[0][kk] = *(const LAS bf16x8*)(Kb + ka0 + (((4 * kk + fq) ^ fr) << 4));
            ckr[0] = *(const LAS f32x4*)(cks + 4 * fq);
#pragma unroll
            for (int k16 = 0; k16 < 4; ++k16) {
                if (k16 < 3) {
#pragma unroll
                    for (int kk = 0; kk < 4; ++kk) kfr[(k16 + 1) & 1][kk] = *(const LAS bf16x8*)(Kb + (k16 + 1) * 4096 + ka0 + (((4 * kk + fq) ^ fr) << 4));
                    ckr[(k16 + 1) & 1] = *(const LAS f32x4*)(cks + 16 * (k16 + 1) + 4 * fq); }
                __builtin_amdgcn_sched_barrier(0);
                f32x4 a0 = cm0 - ckr[k16 & 1], a1 = cm1 - ckr[k16 & 1];
#pragma unroll
                for (int kk = 0; kk < 4; ++kk) { a0 = MFMA16(kfr[k16 & 1][kk], qf[0][kk], a0); a1 = MFMA16(kfr[k16 & 1][kk], qf[1][kk], a1); }
                st[0][k16] = a0; st[1][k16] = a1; }
            if (band) {
#pragma unroll
                for (int qt = 0; qt < 2; ++qt)
#pragma unroll
                    for (int k16 = 0; k16 < 4; ++k16)
#pragma unroll
                        for (int j = 0; j < 4; ++j) if (64 * kt + 16 * k16 + 4 * fq + j > qpos[qt]) st[qt][k16][j] = -INFINITY; }
            float mx[2];
#pragma unroll
            for (int qt = 0; qt < 2; ++qt) { float m_ = -INFINITY;
#pragma unroll
                for (int k16 = 0; k16 < 4; ++k16)
#pragma unroll
                    for (int j = 0; j < 4; ++j) m_ = fmaxf(m_, st[qt][k16][j]);
                m_ = fmaxf(m_, __shfl_xor(m_, 16)); m_ = fmaxf(m_, __shfl_xor(m_, 32)); mx[qt] = m_; }
            const bool first = (kt == 0);
            if (first || __any((mx[0] > 8.f) || (mx[1] > 8.f))) {
#pragma unroll
                for (int qt = 0; qt < 2; ++qt) { const float delta = first ? mx[qt] : fmaxf(mx[qt], 0.f); const float alpha = first ? 1.f : ex2(-delta); mrun[qt] += delta;
                    lrun[qt] *= alpha;
#pragma unroll
                    for (int et = 0; et < 8; ++et) ot[qt][et] = ot[qt][et] * alpha;
#pragma unroll
                    for (int k16 = 0; k16 < 4; ++k16) st[qt][k16] = st[qt][k16] - delta; } }
#pragma unroll
            for (int qt = 0; qt < 2; ++qt) { float ps = 0.f;
#pragma unroll
                for (int k16 = 0; k16 < 4; ++k16)
#pragma unroll
                    for (int j = 0; j < 4; ++j) { const float p = ex2(st[qt][k16][j]); st[qt][k16][j] = p; ps += p; }
                lrun[qt] += ps; }
            bf16x8 pf[2][2];
#pragma unroll
            for (int qt = 0; qt < 2; ++qt)
#pragma unroll
                for (int kb = 0; kb < 2; ++kb) { u32x4 pw; pw.x = pk2(st[qt][2 * kb][0], st[qt][2 * kb][1]); pw.y = pk2(st[qt][2 * kb][2], st[qt][2 * kb][3]);
                    pw.z = pk2(st[qt][2 * kb + 1][0], st[qt][2 * kb + 1][1]); pw.w = pk2(st[qt][2 * kb + 1][2], st[qt][2 * kb + 1][3]); pf[qt][kb] = __builtin_bit_cast(bf16x8, pw); }
            { bf16x8 vfr[2][2];
#pragma unroll
              for (int kb = 0; kb < 2; ++kb) vfr[0][kb] = *(const LAS bf16x8*)(Kb + va0 + (((4 * kb + fq) ^ (fr >> 1)) << 4));
#pragma unroll
              for (int et = 0; et < 8; ++et) {
                if (et < 7) {
#pragma unroll
                    for (int kb = 0; kb < 2; ++kb) vfr[(et + 1) & 1][kb] = *(const LAS bf16x8*)(Kb + (et + 1) * 2048 + va0 + (((4 * kb + fq) ^ (fr >> 1)) << 4)); }
                __builtin_amdgcn_sched_barrier(0);
#pragma unroll
                for (int kb = 0; kb < 2; ++kb) { ot[0][et] = MFMA16(vfr[et & 1][kb], pf[0][kb], ot[0][et]); ot[1][et] = MFMA16(vfr[et & 1][kb], pf[1][kb], ot[1][et]); } } }
        }
        if (kt + 1 < ntile) FOX_CKS((kt + 1) & 1);
        asm volatile("s_waitcnt vmcnt(0)" ::: "memory");
        LBAR();
    }
#undef FOX_DMA
#undef FOX_CKS
#pragma unroll
    for (int qt = 0; qt < 2; ++qt) { float l = lrun[qt]; l += __shfl_xor(l, 16); l += __shfl_xor(l, 32); const float inv = 1.f / l;
        const bf16_t* gp = Z + (size_t)(24 + h) * ZS + (size_t)(rowb + qpos[qt]) * 128 + 4 * fq;
        bf16_t* op = O + (size_t)(rowb + qpos[qt]) * DM + h * 128 + 4 * fq;
#pragma unroll
        for (int et = 0; et < 8; ++et) { const u32x2 gr = *(const u32x2*)(gp + 16 * et);
            const float g0 = sigmoidf_(bf2f((unsigned short)(gr.x & 0xffffu))), g1 = sigmoidf_(bf2f((unsigned short)(gr.x >> 16))), g2 = sigmoidf_(bf2f((unsigned short)(gr.y & 0xffffu))), g3 = sigmoidf_(bf2f((unsigned short)(gr.y >> 16)));
            u32x2 wv; wv.x = pk2(ot[qt][et][0] * inv * g0, ot[qt][et][1] * inv * g1); wv.y = pk2(ot[qt][et][2] * inv * g2, ot[qt][et][3] * inv * g3); *(u32x2*)(op + 16 * et) = wv; } }
}

#define XB_TMO      128
#define XB_XCNT(j)  (256  + 64 * (j))
#define XB_XSUB(j)  (1280 + 64 * (j))
#define XB_XGEN(j)  (2304 + 64 * (j))
#define XB_TOP      3328
#define XB_TOPGEN   3392
#define XCD_BAR_WORDS 3456
#define XB_SPIN_CAP (1u << 18)

__device__ __forceinline__ unsigned xb_ld(unsigned* p)              { return __hip_atomic_load(p, __ATOMIC_RELAXED, __HIP_MEMORY_SCOPE_AGENT); }
__device__ __forceinline__ unsigned xb_add(unsigned* p, unsigned v) { return __hip_atomic_fetch_add(p, v, __ATOMIC_RELAXED, __HIP_MEMORY_SCOPE_AGENT); }
__device__ __forceinline__ unsigned xb_xcc_id() { return (unsigned)__builtin_amdgcn_s_getreg((3 << 11) | 20) & 0xFu; }
#define XB_SPIN(cond, bar) do { unsigned _sp = 0; while (cond) { __builtin_amdgcn_s_sleep(1); \
    if ((++_sp & 255u) == 0u) { if (xb_ld(&(bar)[XB_TMO])) break; if (_sp > XB_SPIN_CAP) { atomicAdd(&(bar)[XB_TMO], 1u); break; } } } } while (0)

struct XcdBarrier {
    unsigned* bar; unsigned x;
    volatile LAS unsigned* st;
};

__device__ __forceinline__ XcdBarrier xcd_barrier_post(unsigned* bar, volatile LAS unsigned* st) {
    XcdBarrier b; b.bar = bar; b.x = xb_xcc_id(); b.st = st;
    if (threadIdx.x == 0) (void)xb_add(&bar[XB_XCNT(b.x)], 1u);
    return b;
}
__device__ __forceinline__ void xcd_barrier_complete(unsigned* bar, unsigned x, unsigned& nloc, unsigned& nx) {
    const unsigned G = gridDim.x * gridDim.y * gridDim.z;
    unsigned sum, cnt, mine, sp = 0u;
    for (;;) {
        sum = 0u; cnt = 0u; mine = 0u;
#pragma unroll
        for (unsigned j = 0; j < 16; ++j) { const unsigned c = xb_ld(&bar[XB_XCNT(j)]); sum += c; cnt += (c > 0u) ? 1u : 0u; mine = (j == x) ? c : mine; }
        if (sum == G) break;
        __builtin_amdgcn_s_sleep(1);
        if ((++sp & 255u) == 0u) { if (xb_ld(&bar[XB_TMO])) break; if (sp > XB_SPIN_CAP) { atomicAdd(&bar[XB_TMO], 1u); break; } }
    }
    nloc = mine > 0u ? mine : 1u; nx = cnt > 0u ? cnt : 1u;
}

__device__ __forceinline__ void xcd_barrier(const XcdBarrier& b) {
    asm volatile("s_waitcnt vmcnt(0)" ::: "memory");
    __syncthreads();
    int tl_ = threadIdx.x; asm volatile("" : "+v"(tl_));
    if (tl_ == 0) {
        unsigned* bar = b.bar;
        __builtin_amdgcn_s_waitcnt(0);
        unsigned nloc = b.st[0], nx = b.st[1];
        if (nloc == 0u) { xcd_barrier_complete(bar, b.x, nloc, nx); b.st[0] = nloc; b.st[1] = nx; }
        const unsigned old = xb_add(&bar[XB_XSUB(b.x)], 1u);
        const unsigned gen = old / nloc;
        if (old + 1u == (gen + 1u) * nloc) {
            __builtin_amdgcn_fence(__ATOMIC_RELEASE, "agent");
            asm volatile("s_waitcnt vmcnt(0)" ::: "memory");
            const unsigned og = xb_add(&bar[XB_TOP], 1u);
            const unsigned tg = og / nx;
            if (og + 1u == (tg + 1u) * nx) xb_add(&bar[XB_TOPGEN], 1u);
            else XB_SPIN(xb_ld(&bar[XB_TOPGEN]) == tg, bar);
            __builtin_amdgcn_fence(__ATOMIC_ACQUIRE, "agent");
            xb_add(&bar[XB_XGEN(b.x)], 1u);
            asm volatile("s_waitcnt vmcnt(0)" ::: "memory");
        } else {
            XB_SPIN(xb_ld(&bar[XB_XGEN(b.x)]) == gen, bar);
            __builtin_amdgcn_fence(__ATOMIC_ACQUIRE, "agent");
            asm volatile("s_waitcnt vmcnt(0)" ::: "memory");
        }
    }
    __syncthreads();
}

#define REP_SCAN1 1
#define REP_SCAN2 1
#define REP_P0 1
#define REP_N3 1
#define REP_G6X 0
#define REP_FOX 1
#define REP_G1 1
#define REP_XA 1
#define REP_SYNC 0
#define REP_G2 1
#ifndef PHM
#define PHM 0xffff
#endif
#ifndef DBG_STOP
#define DBG_STOP 6
#endif
struct Params { const float* in[24]; float* out; unsigned char* ws; };
__global__ void __launch_bounds__(512) mega_fwd(Params P) {
    extern __shared__ __attribute__((aligned(16))) unsigned char lds_raw[];
    LAS unsigned char* lds = (LAS unsigned char*)lds_raw;
    cg::grid_group grid = cg::this_grid();
    { volatile LAS unsigned* st0 = (volatile LAS unsigned*)(lds + 147440); if (threadIdx.x < 4) st0[threadIdx.x] = 0u; }
    __syncthreads();
    (void)xcd_barrier_post((unsigned*)(P.ws + 4096), (volatile LAS unsigned*)(lds + 147440));
#define GSYNC() do { XcdBarrier b_; b_.bar = (unsigned*)(P.ws + 4096); b_.x = xb_xcc_id(); b_.st = (volatile LAS unsigned*)(lds + 147440); xcd_barrier(b_); } while (0)
    const int tid = threadIdx.x, lane = tid & 63, wave = __builtin_amdgcn_readfirstlane(tid >> 6);
    const int G = gridDim.x, bx = blockIdx.x;
    const int gw = bx * 8 + wave, ngw = G * 8;
#define LANE_L() ({ int t_ = threadIdx.x; asm volatile("" : "+v"(t_)); t_ & 63; })
    unsigned char* ws = P.ws;
    const float* x = P.in[0];
    float* hres = P.out; bf16_t* R0 = (bf16_t*)P.out; bf16_t* R1 = R0 + (size_t)T * DM;
    float* G0 = (float*)(ws + WS_G0); float* FG = (float*)(ws + WS_FG); float* CUM = (float*)(ws + WS_CUM);
    bf16_t* MEMN = (bf16_t*)(ws + WS_MEMN); bf16_t* MEMKV = (bf16_t*)(ws + WS_MEMKV);
    bf16_t* Zb = (bf16_t*)(ws + WS_Z); bf16_t* A1 = (bf16_t*)(ws + WS_A1); bf16_t* A2 = (bf16_t*)(ws + WS_A2);
    bf16_t* WinA = (bf16_t*)(ws + W_INA); bf16_t* WinC = (bf16_t*)(ws + W_INC); bf16_t* WoutA = (bf16_t*)(ws + W_OUTA); bf16_t* WoutC = (bf16_t*)(ws + W_OUTC);
    bf16_t* Wkv = (bf16_t*)(ws + W_KV); bf16_t* W1 = (bf16_t*)(ws + W_1); bf16_t* W2 = (bf16_t*)(ws + W_2);

    float* RS = (float*)(ws + WS_RS);
    pg8::PG8F xsl = (pg8::PG8F)(lds + 131072);
#pragma unroll 1
    for (int rep_ = 0; rep_ < REP_P0; ++rep_) {
        LAS float* scr = (LAS float*)(lds + wave * 16384);
        { const int ln_ = LANE_L();
#define TJOB(W_, K_, pitch_, ncols_, gapat_, gap_, WT_, gk_) { constexpr int nblk_ = (ncols_) / 32, items_ = ((K_) / 64) * nblk_; \
            if (r_ < items_) { const int kb_ = r_ / nblk_, n0_ = 32 * (r_ % nblk_); transpose_item(W_, K_, pitch_, n0_ + (n0_ >= (gapat_) ? (gap_) : 0), WT_, n0_, scr, kb_, ln_, gk_); continue; } r_ -= items_; }
          constexpr int NITEMS_P0 = 2 * 2048 + 2 * 512 + 1024 + 4 * 512 + 2 * 2048;
#pragma unroll 1
          for (int it = gw; it < NITEMS_P0; it += ngw) { int r_ = it;
            TJOB(P.in[6], 1024, 4104, 4096, 2048, 8, WinA, nullptr)
            TJOB(P.in[13], 1024, 4104, 4096, 1 << 30, 0, WinC, P.in[2] + 1024)
            TJOB(P.in[22], 1024, 4096, 4096, 1 << 30, 0, W1, P.in[4])
            TJOB(P.in[23], 4096, 1024, 1024, 1 << 30, 0, W2, nullptr)
            TJOB(P.in[19], 1024, 2048, 2048, 1 << 30, 0, Wkv, nullptr)
            TJOB(P.in[12], 1024, 1024, 1024, 1 << 30, 0, WoutA, nullptr)
            TJOB(P.in[17], 1024, 1024, 1024, 1 << 30, 0, WoutC, nullptr)
            TJOB(P.in[20], 1024, 1024, 1024, 1 << 30, 0, (bf16_t*)(ws + W_Q0), P.in[3])
            TJOB(P.in[20] + 1024 * 1024, 1024, 1024, 1024, 1 << 30, 0, (bf16_t*)(ws + W_Q1), P.in[3] + 1024)
            TJOB(P.in[21], 1024, 1024, 1024, 1 << 30, 0, (bf16_t*)(ws + W_O0), nullptr)
            TJOB(P.in[21] + 1024 * 1024, 1024, 1024, 1024, 1 << 30, 0, (bf16_t*)(ws + W_O1), nullptr)
          }
#undef TJOB
        }
        __syncthreads();
        stage_gate_w(P.in[6], 4104, 2048, (LAS float*)lds);
        __syncthreads();
        norm_rows<false, 1>(x, P.in[2], A1, T, gw, ngw, LANE_L(), (const LAS float*)lds, P.in[8], G0);
        norm_rows<false, 0>(P.in[1], P.in[18], MEMN, 1024, gw, ngw, LANE_L(), (const LAS float*)lds, nullptr, nullptr);
        __syncthreads();
    }
    GSYNC();
    if (P.ws == nullptr) grid.sync();
#pragma unroll 1
    for (int rep_ = 0; rep_ < REP_G1; ++rep_)
    { pg8::Gemm g{A1, WinA, T, 4096, 1024}; pg8::StaticOrder S; S.init(T, 4096, G, bx);
      pg8::EpiBf16<0> E{Zb, ZW, 1.f, nullptr, (size_t)ZS}; pg8::gemm_phase<pg8::EpiBf16<0>, pg8::StaticOrder, true, true>(lds, g, S, E); }
    GSYNC();
    { const int sid = (G == 256) ? (bx & 7) * 32 + (bx >> 3) : bx;
      const int mixer = sid >> 7, r = sid & 127, sb = r >> 5, sh = (r >> 3) & 3, sg = r & 7;
      float* LOC = (float*)(ws + WS_A1); float* VEC = (float*)(ws + WS_VEC); const float* MS = (const float*)(ws + WS_MS); const float* DCG = (const float*)(ws + WS_DCG);
      if (sg == 7) {
        pg8::Gemm g{MEMN, Wkv, 1024, 2048, 1024}; pg8::StaticOrder S; S.init(1024, 2048, 32, sid >> 3);
        pg8::EpiBf16<0> E{MEMKV, 2048, 1.f, nullptr, 0}; pg8::gemm_phase<pg8::EpiBf16<0>, pg8::StaticOrder, true, true>(lds, g, S, E); }
#pragma unroll 1
      for (int rep_ = 0; rep_ < REP_SCAN1; ++rep_)
      if (G == 256) {
        if (mixer == 0 && sg != 7) { if (wave == 0) mlstm_prescan(G0, (float*)(ws + WS_MS), (float*)(ws + WS_DCG), sb * 4 + sh, LANE_L()); __syncthreads(); }
        if (mixer == 0) scan_group<true, false>(lds, sb, sh, sg, sid, Zb, G0, P.in[7], nullptr, P.in[10], A2, LOC, VEC, MS, DCG);
        else scan_group<false, false>(lds, sb, sh, sg, sid, Zb, nullptr, nullptr, P.in[9], P.in[11], A2, LOC, VEC, MS, DCG);
      }
      GSYNC();
#pragma unroll 1
      for (int rep_ = 0; rep_ < REP_SCAN2; ++rep_)
      if (G == 256) {
        if (mixer == 0) scan_group<true, true>(lds, sb, sh, sg, sid, Zb, G0, P.in[7], nullptr, P.in[10], A2, LOC, VEC, MS, DCG);
        else scan_group<false, true>(lds, sb, sh, sg, sid, Zb, nullptr, nullptr, P.in[9], P.in[11], A2, LOC, VEC, MS, DCG);
      } }
    GSYNC();
#pragma unroll 1
    for (int rep_ = 0; rep_ < REP_G2; ++rep_)
    { pg8::Gemm g{A2, WoutA, T, 1024, 1024}; pg8::StaticOrder S; S.init(T, 1024, G, bx);
      pg8::EpiResB E{x, 1, R0, RS, xsl}; pg8::gemm_phase<pg8::EpiResB, pg8::StaticOrder, true, true>(lds, g, S, E); }
    xattn_vt_prep(MEMKV, MEMN, bx * 512 + tid);
    GSYNC();
#pragma unroll
    for (int layer = 0; layer < 2; ++layer) {
        if (layer == 1) {
            { LAS float* scr = (LAS float*)(lds + wave * 16384);
              { const int ln_ = LANE_L();
#define TJOB(W_, K_, pitch_, ncols_, WT_, gk_) { constexpr int nblk_ = (ncols_) / 32, items_ = ((K_) / 64) * nblk_; \
                if (r_ < items_) { const int kb_ = r_ / nblk_, n0_ = 32 * (r_ % nblk_); transpose_item(W_, K_, pitch_, n0_, WT_, n0_, scr, kb_, ln_, gk_); continue; } r_ -= items_; }
#pragma unroll 1
                for (int it = gw; it < 4096; it += ngw) { int r_ = it;
                  TJOB(P.in[22] + (size_t)1024 * 4096, 1024, 4096, 4096, W1, P.in[4] + 1024)
                  TJOB(P.in[23] + (size_t)1024 * 4096, 4096, 1024, 1024, W2, nullptr) }
#undef TJOB
              }
              __syncthreads();
              stage_gate_w(P.in[13], 4104, 4096, (LAS float*)lds);
              __syncthreads();
              norm_rows<false, 2, true, true>(R0, P.in[2] + 1024, nullptr, T, gw, ngw, LANE_L(), (const LAS float*)lds, P.in[14], FG); __syncthreads(); }
            { pg8::Gemm g{R0, WinC, T, 4096, 1024}; pg8::StaticOrder S; S.init(T, 4096, G, bx);
              pg8::EpiZ1 E{Zb, (size_t)ZS, P.in[15], P.in[16], xsl, A2, RS + 4 * 4 * T}; pg8::gemm_phase<pg8::EpiZ1, pg8::StaticOrder, true, true>(lds, g, S, E); }
            GSYNC();
#pragma unroll 1
            for (int rep_ = 0; rep_ < REP_FOX; ++rep_)
            for (int u = bx; u < 256; u += G) { const int xcd_ = u & 7, li_ = u >> 3; const int bh = xcd_ * 4 + (li_ >> 3), pr = li_ & 7;
                fox_cumsum_lds(lds, FG, bh >> 3, bh & 7);
#pragma unroll 1
                for (int hf = 0; hf < 2; ++hf) fox_unit(lds, bh >> 3, bh & 7, hf ? pr : 15 - pr, Zb, A2, A1); }
            GSYNC();
            { pg8::Gemm g{A1, WoutC, T, 1024, 1024}; pg8::StaticOrder S; S.init(T, 1024, G, bx);
              pg8::EpiResB E{R0, 0, R1, RS + 2 * 4 * T, xsl}; pg8::gemm_phase<pg8::EpiResB, pg8::StaticOrder, true, true>(lds, g, S, E); }
            GSYNC();
        }
        bf16_t* Rin = layer ? R1 : R0; bf16_t* Rmid = layer ? A2 : R1; bf16_t* Rout = R0;
        { pg8::Gemm g{Rin, (bf16_t*)(ws + (layer ? W_Q1 : W_Q0)), T, 1024, 1024}; pg8::StaticOrder S; S.init(T, 1024, G, bx);
          pg8::EpiBf16<0> E{A2, DM, 0.0625f * LOG2E, RS + (2 * layer) * 4 * T, 0}; pg8::gemm_phase<pg8::EpiBf16<0>, pg8::StaticOrder, true, true>(lds, g, S, E);
          __syncthreads();
          { pg8::StaticOrder S2; S2.init(T, 1024, G, bx); pg8::Unit un;
#pragma unroll 1
            for (int i = 0; S2.next(i, un); ++i) xattn_phase(lds, A2, MEMKV, MEMN, A1, 2 * un.pm, un.pn); } }
        GSYNC();
        { pg8::Gemm g{A1, (bf16_t*)(ws + (layer ? W_O1 : W_O0)), T, 1024, 1024}; pg8::StaticOrder S; S.init(T, 1024, G, bx);
          pg8::EpiResB E{Rin, 0, Rmid, RS + (2 * layer + 1) * 4 * T, xsl}; pg8::gemm_phase<pg8::EpiResB, pg8::StaticOrder, true, true>(lds, g, S, E); }
        GSYNC();
        { pg8::Gemm g{Rmid, W1, T, FF, 1024}; pg8::StaticOrder S; S.init(T, FF, G, bx);
          pg8::EpiBf16<2> E{Zb, FF, 1.f, RS + (2 * layer + 1) * 4 * T, 0}; pg8::gemm_phase<pg8::EpiBf16<2>, pg8::StaticOrder, true, true>(lds, g, S, E); }
        GSYNC();
#pragma unroll 1
        for (int rep_ = 0; rep_ < REP_G6X; ++rep_)
        { pg8::Gemm g{Zb, W2, T, 1024, FF}; pg8::StaticOrder S; S.init(T, 1024, G, bx);
          pg8::EpiBf16<0> E{A1, DM, 1.f, nullptr, 0}; pg8::gemm_phase<pg8::EpiBf16<0>, pg8::StaticOrder, true, true>(lds, g, S, E); }
        { pg8::Gemm g{Zb, W2, T, 1024, FF}; pg8::StaticOrder S; S.init(T, 1024, G, bx);
          if (layer == 0) { pg8::EpiResB E{Rmid, 0, Rout, RS + 4 * 4 * T, xsl}; pg8::gemm_phase<pg8::EpiResB, pg8::StaticOrder, true, true>(lds, g, S, E); }
          else { pg8::EpiResFinal E{Rmid, hres, P.in[5], RS + 4 * 4 * T, (unsigned*)(ws + 32768), xsl}; pg8::gemm_phase<pg8::EpiResFinal, pg8::StaticOrder, true, true>(lds, g, S, E); } }
        if (layer == 0) GSYNC();
    }
}

extern "C" void kernel_launch(void* const* d_in, const int* in_sizes, int n_in, void* d_out, int out_size, void* d_ws, size_t ws_size, hipStream_t stream) {
    static int grid = 0;
    if (grid == 0) {
        if (n_in != 24 || out_size != T * DM || ws_size < ((size_t)254 << 20)) { fprintf(stderr, "kernel_launch: unexpected problem (n_in %d out %d ws %zu)\n", n_in, out_size, ws_size); grid = -1; return; }
        int dev = 0, cus = 0, per_cu = 0;
        hipGetDevice(&dev); hipDeviceGetAttribute(&cus, hipDeviceAttributeMultiprocessorCount, dev);
        if (hipFuncSetAttribute((const void*)mega_fwd, hipFuncAttributeMaxDynamicSharedMemorySize, LDS_BYTES) != hipSuccess) { fprintf(stderr, "hipFuncSetAttribute failed\n"); grid = -1; return; }
        if (hipOccupancyMaxActiveBlocksPerMultiprocessor(&per_cu, (const void*)mega_fwd, 512, LDS_BYTES) != hipSuccess || per_cu < 1) { fprintf(stderr, "occupancy query: %d\n", per_cu); per_cu = 1; }
        (void)hipGetLastError();
        grid = cus * per_cu;
    }
    if (grid < 0) return;
    if (hipMemsetAsync((char*)d_ws, 0, 65536, stream) != hipSuccess) { fprintf(stderr, "memset failed\n"); return; }
    Params p{};
    for (int i = 0; i < 24; ++i) p.in[i] = (const float*)d_in[i];
    p.out = (float*)d_out; p.ws = (unsigned char*)d_ws;
    void* args[] = {&p};
    hipError_t e = hipLaunchCooperativeKernel((const void*)mega_fwd, dim3(grid), dim3(512), args, LDS_BYTES, stream);
    if (e != hipSuccess) fprintf(stderr, "cooperative launch failed: %s (grid %d)\n", hipGetErrorString(e), grid);
}
```
